# Optimizing an MI355X kernel written in HIP

```python
import jax, jax.numpy as jnp
from jax import lax
import numpy as np

D_MODEL = 1024
BATCH = 8
SEQ = 4096
DEPTH = 1

CHUNK = 64
N_LEFT_CHUNKS = 8
BAND = (N_LEFT_CHUNKS + 1) * CHUNK
ATT_HEAD_DIM = 64
ATT_HEADS = (D_MODEL // 2) // ATT_HEAD_DIM
ATT_WIDTH = ATT_HEADS * ATT_HEAD_DIM
REL_CLIP = 128
GMLP_GROUP_DIM = 128
GMLP_GROUPS = (D_MODEL // 2) // GMLP_GROUP_DIM
GMLP_WIDTH = GMLP_GROUPS * GMLP_GROUP_DIM
GMLP_BLOCK = 128
MIX_WIDTH = ATT_WIDTH + GMLP_WIDTH
IN_PROJ_WIDTH = 3 * ATT_WIDTH + 2 * GMLP_WIDTH
N_EXPERTS = 32
TOP_K = 4
D_EXPERT = D_MODEL
SWIGLU_LIMIT = 7.0
SWIGLU_ALPHA = 1.702
MOE_BLOCK = 256
EPS = 1e-6
NEG_INF = -1e30

kernel_name = 'hybrid_chunked_attn_gmlp_moe'


def rms_norm(x, g):
    x32 = x.astype(jnp.float32)
    y = x32 * lax.rsqrt(jnp.mean(x32 * x32, axis=-1, keepdims=True) + EPS)
    return y.astype(x.dtype) * g


def chunked_attention(q, k, v, rel_bias):
    b, s, h, dh = q.shape
    n_chunks = s // CHUNK
    left = BAND - CHUNK
    k_pad = jnp.pad(k, ((0, 0), (left, 0), (0, 0), (0, 0)))
    v_pad = jnp.pad(v, ((0, 0), (left, 0), (0, 0), (0, 0)))
    q_idx = jnp.arange(CHUNK)
    k_idx = jnp.arange(BAND)
    dist = left + q_idx[:, None] - k_idx[None, :]
    bias = rel_bias[:, jnp.clip(dist, -REL_CLIP, REL_CLIP) + REL_CLIP].astype(jnp.float32)
    scale = ATT_HEAD_DIM ** -0.5

    def attend_chunk(c):
        start = c * CHUNK
        qc = lax.dynamic_slice_in_dim(q, start, CHUNK, axis=1)
        kc = lax.dynamic_slice_in_dim(k_pad, start, BAND, axis=1)
        vc = lax.dynamic_slice_in_dim(v_pad, start, BAND, axis=1)
        sc = jnp.einsum('bqhd,bkhd->bhqk', qc, kc).astype(jnp.float32) * scale + bias
        valid = (start - left + k_idx) >= 0
        sc = jnp.where(valid[None, None, None, :], sc, NEG_INF)
        p = jax.nn.softmax(sc, axis=-1).astype(vc.dtype)
        return jnp.einsum('bhqk,bkhd->bqhd', p, vc)

    out = lax.map(attend_chunk, jnp.arange(n_chunks))
    return jnp.transpose(out, (1, 0, 2, 3, 4)).reshape(b, s, h * dh)


def gmlp_spatial_gating(u, v, v_norm_g, w_s, b_s):
    b, s, _ = u.shape
    n_blocks = s // GMLP_BLOCK
    u = jax.nn.gelu(u, approximate=False)
    v = jax.nn.gelu(v, approximate=False).reshape(b, n_blocks, GMLP_BLOCK, GMLP_GROUPS, GMLP_GROUP_DIM)
    v = rms_norm(v, v_norm_g)
    pos_chunk = jnp.arange(GMLP_BLOCK) // CHUNK
    mask = (pos_chunk[:, None] >= pos_chunk[None, :]).astype(w_s.dtype)
    gate = jnp.einsum('gij,bnjgc->bnigc', w_s * mask[None], v) + b_s.T[:, :, None]
    return u * gate.reshape(b, s, GMLP_WIDTH)


def moe_ffn(xn, w_router, b_router, w_expert_in, b_expert_in, w_expert_out, b_expert_out):
    b, s, d = xn.shape
    t = b * s
    n_assign = t * TOP_K
    xt = xn.reshape(t, d)
    logits = (xt @ w_router + b_router).astype(jnp.float32)
    top_val, top_idx = lax.top_k(logits, TOP_K)
    gates = jax.nn.softmax(top_val, axis=-1).astype(xn.dtype)
    flat_e = top_idx.reshape(-1)
    flat_tok = jnp.arange(n_assign, dtype=jnp.int32) // TOP_K
    order = jnp.argsort(flat_e)
    sorted_e = flat_e[order]
    sorted_tok = flat_tok[order]
    sorted_gate = gates.reshape(-1)[order]
    counts = jnp.zeros((N_EXPERTS,), jnp.int32).at[flat_e].add(1)
    starts = jnp.cumsum(counts) - counts
    padded = ((counts + MOE_BLOCK - 1) // MOE_BLOCK) * MOE_BLOCK
    pad_ends = jnp.cumsum(padded)
    pad_starts = pad_ends - padded
    dest = pad_starts[sorted_e] + (jnp.arange(n_assign, dtype=jnp.int32) - starts[sorted_e])
    n_blocks = -(-n_assign // MOE_BLOCK) + N_EXPERTS
    x_pad = jnp.zeros((n_blocks * MOE_BLOCK, d), xt.dtype).at[dest].set(xt[sorted_tok])
    block_start = jnp.arange(n_blocks, dtype=jnp.int32) * MOE_BLOCK
    block_e = jnp.minimum(jnp.sum(pad_ends[None, :] <= block_start[:, None], axis=1), N_EXPERTS - 1)

    def expert_block(args):
        xb, e = args
        hdn = xb @ w_expert_in[e] + b_expert_in[e]
        g, lin = hdn[:, :D_EXPERT], hdn[:, D_EXPERT:]
        g = jnp.minimum(g, SWIGLU_LIMIT)
        lin = jnp.clip(lin, -SWIGLU_LIMIT, SWIGLU_LIMIT)
        act = g * jax.nn.sigmoid(SWIGLU_ALPHA * g) * (lin + 1)
        return act @ w_expert_out[e] + b_expert_out[e]

    y_pad = lax.map(expert_block, (x_pad.reshape(n_blocks, MOE_BLOCK, d), block_e)).reshape(-1, d)
    y = y_pad[dest] * sorted_gate[:, None]
    out = jnp.zeros((t, d), xn.dtype).at[sorted_tok].add(y)
    return out.reshape(b, s, d)


def setup_inputs(seed: int = 0) -> dict:
    key = jax.random.key(seed)
    ks = jax.random.split(key, 20)
    f32 = jnp.float32
    nrm = lambda k, shape, sc: jax.random.normal(k, shape, f32) * sc
    return {
        'x': nrm(ks[0], (BATCH, SEQ, D_MODEL), 1.0),
        'norm_mix_g': 1.0 + nrm(ks[1], (D_MODEL,), 0.05),
        'w_in_proj': nrm(ks[2], (D_MODEL, IN_PROJ_WIDTH), D_MODEL ** -0.5),
        'q_norm_g': 1.0 + nrm(ks[3], (ATT_HEAD_DIM,), 0.05),
        'k_norm_g': 1.0 + nrm(ks[4], (ATT_HEAD_DIM,), 0.05),
        'rel_bias': nrm(ks[5], (ATT_HEADS, 2 * REL_CLIP + 1), 0.5),
        'gmlp_v_norm_g': 1.0 + nrm(ks[6], (GMLP_GROUPS, GMLP_GROUP_DIM), 0.05),
        'gmlp_w_s': nrm(ks[7], (GMLP_GROUPS, GMLP_BLOCK, GMLP_BLOCK), GMLP_BLOCK ** -0.5),
        'gmlp_b_s': 1.0 + nrm(ks[8], (GMLP_GROUPS, GMLP_BLOCK), 0.1),
        'att_out_norm_g': 1.0 + nrm(ks[9], (ATT_WIDTH,), 0.05),
        'gmlp_out_norm_g': 1.0 + nrm(ks[10], (GMLP_WIDTH,), 0.05),
        'w_out_proj': nrm(ks[11], (MIX_WIDTH, D_MODEL), MIX_WIDTH ** -0.5),
        'norm_moe_g': 1.0 + nrm(ks[12], (D_MODEL,), 0.05),
        'w_router': nrm(ks[13], (D_MODEL, N_EXPERTS), D_MODEL ** -0.5),
        'b_router': nrm(ks[14], (N_EXPERTS,), 0.01),
        'w_expert_in': nrm(ks[15], (N_EXPERTS, D_MODEL, 2 * D_EXPERT), D_MODEL ** -0.5),
        'b_expert_in': nrm(ks[16], (N_EXPERTS, 2 * D_EXPERT), 0.02),
        'w_expert_out': nrm(ks[17], (N_EXPERTS, D_EXPERT, D_MODEL), D_EXPERT ** -0.5),
        'b_expert_out': nrm(ks[18], (N_EXPERTS, D_MODEL), 0.02),
    }


def reference(x, norm_mix_g, w_in_proj, q_norm_g, k_norm_g, rel_bias, gmlp_v_norm_g, gmlp_w_s,
              gmlp_b_s, att_out_norm_g, gmlp_out_norm_g, w_out_proj, norm_moe_g, w_router, b_router,
              w_expert_in, b_expert_in, w_expert_out, b_expert_out):
    b, s, _ = x.shape
    h = x
    for _ in range(DEPTH):
        z = rms_norm(h, norm_mix_g)
        proj = z @ w_in_proj
        q, k, v, gu, gv = jnp.split(proj, [ATT_WIDTH, 2 * ATT_WIDTH, 3 * ATT_WIDTH,
                                           3 * ATT_WIDTH + GMLP_WIDTH], axis=-1)
        q = rms_norm(q.reshape(b, s, ATT_HEADS, ATT_HEAD_DIM), q_norm_g)
        k = rms_norm(k.reshape(b, s, ATT_HEADS, ATT_HEAD_DIM), k_norm_g)
        v = v.reshape(b, s, ATT_HEADS, ATT_HEAD_DIM)
        att_out = chunked_attention(q, k, v, rel_bias)
        gmlp_out = gmlp_spatial_gating(gu, gv, gmlp_v_norm_g, gmlp_w_s, gmlp_b_s)
        mixed = jnp.concatenate([rms_norm(att_out, att_out_norm_g),
                                 rms_norm(gmlp_out, gmlp_out_norm_g)], axis=-1)
        h = h + mixed @ w_out_proj
        h = h + moe_ffn(rms_norm(h, norm_moe_g), w_router, b_router, w_expert_in, b_expert_in,
                        w_expert_out, b_expert_out)
    return h
```

```cpp
#include <hip/hip_runtime.h>
#include <cstdio>
#include <cstdint>

#define GAS __attribute__((address_space(1)))
#define LAS __attribute__((address_space(3)))
typedef unsigned short bf16_t;
typedef short bf16x8 __attribute__((ext_vector_type(8)));
typedef short s16x4 __attribute__((ext_vector_type(4)));
typedef float f32x2 __attribute__((ext_vector_type(2)));
typedef float f32x4 __attribute__((ext_vector_type(4)));
typedef float f32x16 __attribute__((ext_vector_type(16)));
typedef unsigned u32x2 __attribute__((ext_vector_type(2)));
typedef unsigned u32x4 __attribute__((ext_vector_type(4)));
typedef int i32x4 __attribute__((ext_vector_type(4)));
typedef int i32x8 __attribute__((ext_vector_type(8)));

#ifndef PROBE_REP
#define PROBE_REP -1
#endif
#define NREP(k) ((k) == PROBE_REP ? 2 : 1)
#ifndef MK_SPLIT
#define MK_SPLIT 0
#endif

constexpr int NBATCH = 8, SEQ = 4096, D = 1024, T = NBATCH * SEQ;
constexpr int NPROJ = 2560, NE = 32, TOPK = 4, DE = 1024;
constexpr int NA = T * TOPK;
constexpr int LISTCAP = T;
constexpr float EPS = 1e-6f;
constexpr float LOG2E = 1.4426950408889634f;
constexpr float C2 = 0.125f * LOG2E;

constexpr size_t MiB = 1u << 20;
constexpr size_t WS_CTL = 0, CTL_ZERO_BYTES = 1 * MiB;
constexpr size_t WS_WIN = 1 * MiB;
constexpr size_t WS_WO = 6 * MiB;
constexpr size_t WS_W1 = 8 * MiB;
constexpr size_t WS_W2 = 136 * MiB;
constexpr size_t WS_HB = 200 * MiB;
constexpr size_t WS_SSQGV = 264 * MiB;
constexpr size_t WS_SSQAT = 265 * MiB;
constexpr size_t WS_GATES = 266 * MiB;
constexpr size_t WS_MH = 266 * MiB + 768 * 1024;
constexpr size_t WS_WSB = 266 * MiB + 832 * 1024;
constexpr size_t WS_LIST = 267 * MiB;
constexpr size_t WS_ACT = 272 * MiB;
constexpr size_t WS_Y = 672 * MiB;
constexpr size_t WS_XB = 544 * MiB;
constexpr size_t WS_MO = 608 * MiB;
constexpr size_t WS_Q = 608 * MiB;
constexpr size_t WS_MIX = 768 * MiB;
constexpr size_t WS_END = 800 * MiB;
constexpr size_t QSTRIDE = (size_t)T * 512;
constexpr int CW_BAR = 4096;
constexpr int CW_ECNT = 16384;
constexpr int CW_W2Q = 17408;

constexpr int RING_BYTES = 131072;
constexpr int LDS_BYTES = 163840;
constexpr int LDS_LCNT = LDS_BYTES - 3072;
constexpr int LDS_PT = LDS_BYTES - 2048;
constexpr int LDS_MISC = LDS_BYTES - 1024;

__device__ __forceinline__ unsigned cvt_pk_bf16(float lo, float hi) { unsigned r; asm volatile("v_cvt_pk_bf16_f32 %0, %1, %2" : "=v"(r) : "v"(lo), "v"(hi)); return r; }
__device__ __forceinline__ float bf2f(unsigned short b) { return __builtin_bit_cast(float, (unsigned)b << 16); }
__device__ __forceinline__ float wave_sum(float v) {
#pragma unroll
    for (int o = 1; o < 64; o <<= 1) v += __shfl_xor(v, o);
    return v;
}
__device__ __forceinline__ float wave_max(float v) {
#pragma unroll
    for (int o = 1; o < 64; o <<= 1) v = fmaxf(v, __shfl_xor(v, o));
    return v;
}
__device__ __forceinline__ int opaque_tid() { int t = threadIdx.x; asm volatile("" : "+v"(t)); return t; }
__device__ __forceinline__ void glds16(const void* gsrc, unsigned lds_dst) { unsigned keep;
    asm volatile("s_mov_b32 %0, m0\n\ts_mov_b32 m0, %2\n\ts_nop 0\n\tglobal_load_lds_dwordx4 %1, off\n\ts_mov_b32 m0, %0" : "=&s"(keep) : "v"(gsrc), "s"(lds_dst) : "memory"); }
__device__ __forceinline__ unsigned lds_addr(const LAS void* p) { return (unsigned)(size_t)p; }
#define LDS_WAIT() asm volatile("s_waitcnt lgkmcnt(0)" ::: "memory")
#define VM_WAIT() asm volatile("s_waitcnt vmcnt(0)" ::: "memory")

__device__ __forceinline__ f32x2 gelu_pk(f32x2 v) {
    const f32x2 av = __builtin_elementwise_abs(v), d = av * 0.2316418882f + 1.0f;
    f32x2 t; t.x = __builtin_amdgcn_rcpf(d.x); t.y = __builtin_amdgcn_rcpf(d.y);
    f32x2 q = t * 0.5307027145f + (-0.7265760135f); q = q * t + 0.7107068705f; q = q * t + (-0.142248368f); q = q * t + 0.127414796f; q = q * t;
    const f32x2 s = (v * v) * (-0.72134752044f);
    f32x2 e; e.x = __builtin_amdgcn_exp2f(s.x); e.y = __builtin_amdgcn_exp2f(s.y);
    const f32x2 m = v * (q * e), r = v - m;
    f32x2 o; o.x = v.x < 0.f ? m.x : r.x; o.y = v.y < 0.f ? m.y : r.y; return o;
}
__device__ __forceinline__ f32x4 gelu4(f32x4 v) { f32x2 a = gelu_pk((f32x2){v[0], v[1]}), b = gelu_pk((f32x2){v[2], v[3]}); return (f32x4){a.x, a.y, b.x, b.y}; }

namespace pg8 {
constexpr int BM = 256, BK = 64, HALF = 128, HTB = HALF * BK * 2, NXCD = 8, WGM = 4, KD = 1024;
__host__ __device__ __forceinline__ int lds_byte(int r, int c) { const int st = (r >> 4) * 2 + (c >> 5), rr = r & 15, cc = c & 31, ob = rr * 64 + cc * 2; return st * 1024 + (ob ^ (((ob >> 9) & 1) << 5)); }
__host__ __device__ __forceinline__ void stage_rc(int b, int& R, int& C) { const int st = b / 1024, sb = b % 1024, swz = sb ^ (((sb >> 9) & 1) << 5); R = (st >> 1) * 16 + swz / 64; C = (st & 1) * 32 + (swz % 64) / 2; }
__host__ __device__ __forceinline__ int perm32(int rho) { const int n = rho >> 4, i = rho & 15; return 8 * (i >> 2) + 4 * n + (i & 3); }

struct Unit { int pm, pn, e, mt, hs; };

struct TileOrder {
    int nM, nN, nwg, G, c;
    __device__ __forceinline__ void init(int nM_, int nN_, int G_, int c_) { nM = nM_; nN = nN_; nwg = nM * nN; G = G_; c = c_; }
    __device__ __forceinline__ bool tile(int i, int& pm, int& pn) const { const long L = (long)i * G + c; if (L >= nwg) return false; tileL((int)L, pm, pn); return true; }
    __device__ __forceinline__ void tileL(int L, int& pm, int& pn) const {
        int wgid = L; { const int q = nwg / NXCD, r = nwg % NXCD, xcd = wgid % NXCD, off = wgid / NXCD; wgid = (xcd < r ? xcd * (q + 1) : r * (q + 1) + (xcd - r) * q) + off; }
        const int nig = WGM * nN, gid = wgid / nig, fm = gid * WGM, gsz = (nM - fm) < WGM ? (nM - fm) : WGM;
        pm = fm + ((wgid % nig) % gsz); pn = (wgid % nig) / gsz;
    }
};

__device__ __forceinline__ i32x8 cat8(bf16x8 a, bf16x8 b) { const i32x4 x = __builtin_bit_cast(i32x4, a), y = __builtin_bit_cast(i32x4, b); return __builtin_shufflevector(x, y, 0, 1, 2, 3, 4, 5, 6, 7); }
template <class Epi, class Sched, bool ALIGN_EPI, bool SP2, bool FP8 = false, bool COL16 = false>
__device__ __forceinline__ void gemm_phase(LAS unsigned char* lds, const Sched& S, const Epi& E) {
    const int tid = opaque_tid(), wid = __builtin_amdgcn_readfirstlane(tid >> 6), lane = tid & 63, wr = wid >> 2, wc = wid & 3, fr = lane & 15, fq = lane >> 4;
    constexpr int K = FP8 ? KD / 2 : KD  , nt = K / BK;
    int sR[2], sC[2];
    unsigned voffB[2], vA[2][2];
#pragma unroll
    for (int i = 0; i < 2; ++i) {
        sR[i] = 8 * (wid + 8 * i) + (lane >> 3); sC[i] = 8 * ((lane & 7) ^ ((sR[i] >> 1) & 7)); const int rho = sR[i] & 31;
        const int Rb = COL16 ? 64 * (sR[i] >> 5) + 16 * ((rho & 15) >> 2) + 4 * (rho >> 4) + (rho & 3) : 64 * (sR[i] >> 5) + perm32(rho);
        voffB[i] = (unsigned)(Rb * K + sC[i]) * 2u;
        vA[0][i] = (unsigned)(sR[i] * K + sC[i]) * 2u; vA[1][i] = (unsigned)((sR[i] + HALF) * K + sC[i]) * 2u; }
    constexpr size_t kstep = (size_t)(BK * 2);
    constexpr size_t hstepB = (size_t)(COL16 ? 8 : 32) * K * 2;
    const unsigned ldsw = (unsigned)wid * 1024u;
    const int aoff0 = (wr * 64 + fr) * 128 + 16 * (fq ^ (fr >> 1)), aoff1 = (wr * 64 + fr) * 128 + 16 * ((4 + fq) ^ (fr >> 1));
    const int boff0 = (wc * 32 + fr) * 128 + 16 * (fq ^ (fr >> 1)), boff1 = (wc * 32 + fr) * 128 + 16 * ((4 + fq) ^ (fr >> 1));
#define PG8_SA(b, h) (((b) * 2 + (h)) * HTB)
#define PG8_SB(b, h) ((4 + (b) * 2 + (h)) * HTB)
#define PG8_STAGE(bufoff, gbase, v0, v1) do { \
        __builtin_amdgcn_global_load_lds((const unsigned*)((const char*)(gbase) + (v0)), (LAS unsigned*)(lds + (bufoff) + ldsw), 16, 0, 0); \
        __builtin_amdgcn_global_load_lds((const unsigned*)((const char*)(gbase) + (v1)), (LAS unsigned*)(lds + (bufoff) + ldsw + 8192), 16, 0, 0); } while (0)
#define PG8_STAGE_B(bufoff, gbase) PG8_STAGE(bufoff, gbase, voffB[0], voffB[1])
#define PG8_STAGE_A(bufoff, gbase, V, h) PG8_STAGE(bufoff, gbase, V[h][0], V[h][1])
#define PG8_LDA(dst, b, h) do { _Pragma("unroll") for (int m = 0; m < 4; ++m) { \
        if constexpr (FP8) { const i32x4 lo_ = *(const LAS i32x4*)(lds + PG8_SA(b, h) + aoff0 + m * 2048), hi_ = *(const LAS i32x4*)(lds + PG8_SA(b, h) + aoff1 + m * 2048); dst##8[m] = __builtin_shufflevector(lo_, hi_, 0, 1, 2, 3, 4, 5, 6, 7); } \
        else { dst[m][0] = *(const LAS bf16x8*)(lds + PG8_SA(b, h) + aoff0 + m * 2048); dst[m][1] = *(const LAS bf16x8*)(lds + PG8_SA(b, h) + aoff1 + m * 2048); } } } while (0)
#define PG8_LDB(dst, b, h) do { _Pragma("unroll") for (int n = 0; n < 2; ++n) { \
        if constexpr (FP8) { const i32x4 lo_ = *(const LAS i32x4*)(lds + PG8_SB(b, h) + boff0 + n * 2048), hi_ = *(const LAS i32x4*)(lds + PG8_SB(b, h) + boff1 + n * 2048); dst##8[n] = __builtin_shufflevector(lo_, hi_, 0, 1, 2, 3, 4, 5, 6, 7); } \
        else { dst[n][0] = *(const LAS bf16x8*)(lds + PG8_SB(b, h) + boff0 + n * 2048); dst[n][1] = *(const LAS bf16x8*)(lds + PG8_SB(b, h) + boff1 + n * 2048); } } } while (0)
#define PG8_MMA(ai, bj, At, Bt) do { __builtin_amdgcn_s_setprio(1); _Pragma("unroll") for (int m = 0; m < 4; ++m) _Pragma("unroll") for (int n = 0; n < 2; ++n) { \
        if constexpr (FP8) asm volatile("v_mfma_scale_f32_16x16x128_f8f6f4 %0, %1, %2, %0, %3, %3 op_sel_hi:[0,0,0]" : "+v"(acc[ai][bj][m][n]) : "v"(Bt##8[n]), "v"(At##8[m]), "v"(scl)); \
        else { _Pragma("unroll") for (int k = 0; k < 2; ++k) acc[ai][bj][m][n] = __builtin_amdgcn_mfma_f32_16x16x32_bf16(Bt[n][k], At[m][k], acc[ai][bj][m][n], 0, 0, 0); } } \
        __builtin_amdgcn_s_setprio(0); } while (0)
#define PG8_WAIT_V(n) asm volatile("s_waitcnt vmcnt(" #n ")" ::: "memory")
#define PG8_WAIT_L(n) asm volatile("s_waitcnt lgkmcnt(" #n ")" ::: "memory")
#define PG8_BAR __builtin_amdgcn_s_barrier()
#define PG8_SCHED __builtin_amdgcn_sched_barrier(0)
    Unit cur, nxt; int ui = 0;
    if (!S.next(0, cur)) return;
    LAS u32x4* const gslot = (LAS u32x4*)(lds + 131072) + tid;
    LAS unsigned char* const metab = lds + 139264;
    if constexpr (Sched::GATHER) { S.gather(cur, sR, sC, vA); Unit u1; if (S.next(1, u1)) { unsigned t_[2][2]; S.gather(u1, sR, sC, t_); *gslot = (u32x4){t_[0][0], t_[0][1], t_[1][0], t_[1][1]}; } }
    if constexpr (Epi::META) E.meta_finish(E.meta_issue(cur, tid), metab, tid);
    f32x4 acc[2][2][4][2];
#pragma unroll
    for (int a = 0; a < 2; ++a)
#pragma unroll
        for (int b = 0; b < 2; ++b)
#pragma unroll
            for (int m = 0; m < 4; ++m)
#pragma unroll
                for (int n = 0; n < 2; ++n) acc[a][b][m][n] = (f32x4){0.f, 0.f, 0.f, 0.f};
    bf16x8 At[4][2], B0[2][2], B1[2][2]; i32x8 At8[4], B08[2], B18[2];
    unsigned scl = 0x7F7F7F7Fu; asm volatile("" : "+v"(scl));
    const char* cA = S.a_ptr(cur); const char* cB = S.b_ptr(cur);
    if constexpr (SP2) {
        PG8_STAGE_B(PG8_SB(0, 0), cB); PG8_STAGE_B(PG8_SB(0, 1), cB + hstepB); PG8_STAGE_A(PG8_SA(0, 0), cA, vA, 0); PG8_STAGE_A(PG8_SA(0, 1), cA, vA, 1);
        if (wr == 1) PG8_BAR;
        PG8_WAIT_V(2); PG8_BAR;
        PG8_STAGE_B(PG8_SB(1, 0), cB + kstep); PG8_STAGE_A(PG8_SA(1, 0), cA + kstep, vA, 0); PG8_STAGE_B(PG8_SB(1, 1), cB + hstepB + kstep);
        PG8_WAIT_V(6); PG8_BAR;
    } else {
        PG8_STAGE_B(PG8_SB(0, 0), cB); PG8_STAGE_A(PG8_SA(0, 0), cA, vA, 0); PG8_STAGE_B(PG8_SB(0, 1), cB + hstepB); PG8_STAGE_A(PG8_SA(0, 1), cA, vA, 1);
        if (wr == 1) PG8_BAR;
        PG8_WAIT_V(4); PG8_BAR;
        PG8_STAGE_B(PG8_SB(1, 0), cB + kstep); PG8_STAGE_A(PG8_SA(1, 0), cA + kstep, vA, 0); PG8_STAGE_B(PG8_SB(1, 1), cB + hstepB + kstep);
        PG8_WAIT_V(6); PG8_BAR;
    }
    for (;;) {
        const bool has_next = S.next(ui + 1, nxt);
        const char* nA = has_next ? S.a_ptr(nxt) : cA; const char* nB = has_next ? S.b_ptr(nxt) : cB;
        unsigned w2[2][2] = {{vA[0][0], vA[0][1]}, {vA[1][0], vA[1][1]}};
        for (int t = 0; t < nt; t += 2) {
            const bool last = (t == nt - 2);
            if constexpr (Epi::HAS_MID) { if (t == nt / 2) E.mid(acc, cur, wr, wc, fr, fq); }
            const char* a1 = cA + (size_t)(t + 1) * kstep;
            const char* a2 = last ? nA : cA + (size_t)(t + 2) * kstep; const char* b2 = last ? nB : cB + (size_t)(t + 2) * kstep;
            const char* a3 = a2 + kstep; const char* b3 = b2 + kstep;
            if constexpr (Sched::GATHER) { if (last && has_next) { const u32x4 r_ = *gslot; w2[0][0] = r_[0]; w2[0][1] = r_[1]; w2[1][0] = r_[2]; w2[1][1] = r_[3]; } }
            if constexpr (SP2) {
            PG8_LDB(B0, 0, 0); PG8_LDB(B1, 0, 1); PG8_SCHED; PG8_LDA(At, 0, 0); PG8_STAGE_A(PG8_SA(1, 1), a1, vA, 1);
            PG8_WAIT_V(8); PG8_WAIT_L(0); PG8_BAR; PG8_MMA(0, 0, At, B0); PG8_MMA(0, 1, At, B1); PG8_BAR; PG8_SCHED;
            if (!Sched::HALVES || cur.hs < 0) PG8_LDA(At, 0, 1); PG8_STAGE_B(PG8_SB(0, 0), b2); PG8_STAGE_B(PG8_SB(0, 1), b2 + hstepB); PG8_STAGE_A(PG8_SA(0, 0), a2, w2, 0);
            PG8_WAIT_V(8); PG8_WAIT_L(0); PG8_BAR; if (!Sched::HALVES || cur.hs < 0) { PG8_MMA(1, 0, At, B0); PG8_MMA(1, 1, At, B1); } PG8_BAR; PG8_SCHED;
            PG8_LDB(B0, 1, 0); PG8_LDB(B1, 1, 1); PG8_SCHED; PG8_LDA(At, 1, 0); PG8_STAGE_A(PG8_SA(0, 1), a2, w2, 1);
            PG8_WAIT_V(8); PG8_WAIT_L(0); PG8_BAR; PG8_MMA(0, 0, At, B0); PG8_MMA(0, 1, At, B1); PG8_BAR; PG8_SCHED;
            if (!Sched::HALVES || cur.hs < 0) PG8_LDA(At, 1, 1); PG8_STAGE_B(PG8_SB(1, 0), b3); PG8_STAGE_B(PG8_SB(1, 1), b3 + hstepB); PG8_STAGE_A(PG8_SA(1, 0), a3, w2, 0);
            PG8_WAIT_V(8); PG8_WAIT_L(0); PG8_BAR; if (!Sched::HALVES || cur.hs < 0) { PG8_MMA(1, 0, At, B0); PG8_MMA(1, 1, At, B1); } PG8_BAR; PG8_SCHED;
            } else {
            PG8_LDB(B0, 0, 0); PG8_SCHED; PG8_LDA(At, 0, 0); PG8_STAGE_A(PG8_SA(1, 1), a1, vA, 1);
            PG8_WAIT_L(8); PG8_BAR; PG8_WAIT_L(0); PG8_MMA(0, 0, At, B0); PG8_BAR; PG8_SCHED;
            PG8_LDB(B1, 0, 1); PG8_STAGE_B(PG8_SB(0, 0), b2);
            PG8_BAR; PG8_WAIT_L(0); PG8_MMA(0, 1, At, B1); PG8_BAR;
            PG8_LDA(At, 0, 1); PG8_STAGE_A(PG8_SA(0, 0), a2, w2, 0);
            PG8_BAR; PG8_WAIT_L(0); PG8_MMA(1, 0, At, B0); PG8_BAR; PG8_SCHED;
            PG8_STAGE_B(PG8_SB(0, 1), b2 + hstepB);
            PG8_WAIT_V(6); PG8_BAR; PG8_MMA(1, 1, At, B1); PG8_BAR;
            PG8_LDB(B0, 1, 0); PG8_SCHED; PG8_LDA(At, 1, 0); PG8_STAGE_A(PG8_SA(0, 1), a2, w2, 1);
            PG8_WAIT_L(8); PG8_BAR; PG8_WAIT_L(0); PG8_MMA(0, 0, At, B0); PG8_BAR; PG8_SCHED;
            PG8_LDB(B1, 1, 1); PG8_STAGE_B(PG8_SB(1, 0), b3);
            PG8_BAR; PG8_WAIT_L(0); PG8_MMA(0, 1, At, B1); PG8_BAR;
            PG8_LDA(At, 1, 1); PG8_STAGE_A(PG8_SA(1, 0), a3, w2, 0);
            PG8_BAR; PG8_WAIT_L(0); PG8_MMA(1, 0, At, B0); PG8_BAR; PG8_SCHED;
            PG8_STAGE_B(PG8_SB(1, 1), b3 + hstepB);
            PG8_WAIT_V(6); PG8_BAR; PG8_MMA(1, 1, At, B1); PG8_BAR;
            }
        }
        if constexpr (ALIGN_EPI) { if (wr == 0) PG8_BAR; }
        if constexpr (FP8) asm volatile("s_nop 15\n\ts_nop 15" ::: "memory");
        {
            Unit n2; bool h2 = false; int raw_[2][2] = {{0, 0}, {0, 0}}; unsigned mreg_ = 0u;
            if constexpr (Sched::GATHER) { h2 = S.next(ui + 2, n2); if (h2) S.gather_issue(n2, sR, raw_); }
            if constexpr (Epi::META) { if (has_next) mreg_ = E.meta_issue(nxt, tid); }
            if constexpr (Epi::META) E.run(acc, cur, wr, wc, fr, fq, metab + (ui & 1) * 2048); else E(acc, cur, wr, wc, fr, fq);
            if constexpr (Sched::GATHER) { if (h2) { unsigned t_[2][2]; S.gather_finish(raw_, sC, t_); *gslot = (u32x4){t_[0][0], t_[0][1], t_[1][0], t_[1][1]}; } }
            if constexpr (Epi::META) { if (has_next) E.meta_finish(mreg_, metab + ((ui + 1) & 1) * 2048, tid); }
        }
        if (!has_next) break;
#pragma unroll
        for (int a = 0; a < 2; ++a)
#pragma unroll
            for (int b = 0; b < 2; ++b)
#pragma unroll
                for (int m = 0; m < 4; ++m)
#pragma unroll
                    for (int n = 0; n < 2; ++n) acc[a][b][m][n] = (f32x4){0.f, 0.f, 0.f, 0.f};
        if constexpr (FP8) asm volatile("s_nop 7" ::: "memory");
        cur = nxt; cA = nA; cB = nB; ++ui;
        if constexpr (Sched::GATHER) {
#pragma unroll
            for (int h = 0; h < 2; ++h)
#pragma unroll
                for (int i = 0; i < 2; ++i) vA[h][i] = w2[h][i];
        }
        if constexpr (ALIGN_EPI) { if (wr == 1) PG8_BAR; }
    }
    PG8_WAIT_V(0);
    if constexpr (!ALIGN_EPI) { if (wr == 0) PG8_BAR; }
    PG8_BAR;
#undef PG8_SA
#undef PG8_SB
#undef PG8_STAGE
#undef PG8_STAGE_A
#undef PG8_STAGE_B
#undef PG8_LDA
#undef PG8_LDB
#undef PG8_MMA
#undef PG8_WAIT_V
#undef PG8_WAIT_L
#undef PG8_BAR
#undef PG8_SCHED
}

struct DenseSched {
    static constexpr bool GATHER = false, HALVES = false; static constexpr int KB = KD * 2;
    TileOrder o; const char* A; const char* Bt;
    __device__ __forceinline__ bool next(int i, Unit& u) const { if (!o.tile(i, u.pm, u.pn)) return false; u.e = 0; u.mt = u.pm; u.hs = -1; return true; }
    __device__ __forceinline__ const char* a_ptr(const Unit& u) const { return A + (size_t)u.pm * ((size_t)BM * KB); }
    __device__ __forceinline__ const char* b_ptr(const Unit& u) const { return Bt + (size_t)u.pn * ((size_t)BM * KB); }
    __device__ __forceinline__ void gather(const Unit&, const int (&)[2], const int (&)[2], unsigned (&)[2][2]) const {}
    __device__ __forceinline__ void gather_issue(const Unit&, const int (&)[2], int (&)[2][2]) const {}
    __device__ __forceinline__ void gather_finish(const int (&)[2][2], const int (&)[2], unsigned (&)[2][2]) const {}
};
template <bool GATHER_, bool HALVES_ = false>
struct GroupSched {
    static constexpr bool GATHER = GATHER_, HALVES = HALVES_; static constexpr int KB = KD;
    TileOrder o; const LAS int* pt; const LAS int* cnt; const char* A; const char* Bt; int nrows; const int* list;
    __device__ __forceinline__ bool next(int i, Unit& u) const {
        u.hs = -1;
        if constexpr (HALVES_) {
            const int fr_ = o.nwg / o.G, tail_ = o.nwg - fr_ * o.G;
            if (i >= fr_ && tail_ > 0 && 2 * tail_ <= o.G) {
                if (i > fr_ || o.c >= 2 * tail_) return false;
                o.tileL(fr_ * o.G + (o.c >> 1), u.pm, u.pn); u.hs = o.c & 1;
            } else if (!o.tile(i, u.pm, u.pn)) return false;
        } else if (!o.tile(i, u.pm, u.pn)) return false;
        const int lane = threadIdx.x & 63;
        const int pe = pt[(lane & 31) + 1];
        const unsigned long long bal = __ballot(u.pm >= pe) & 0xffffffffull;
        const int e = __builtin_amdgcn_readfirstlane(__popcll(bal)); u.e = e > 31 ? 31 : e; u.mt = u.pm - __builtin_amdgcn_readfirstlane(pt[u.e]); return true;
    }
    __device__ __forceinline__ const char* a_ptr(const Unit& u) const { return GATHER ? A : A + (size_t)u.pm * ((size_t)BM * KB) + (u.hs > 0 ? (size_t)HALF * KB : (size_t)0); }
    __device__ __forceinline__ const char* b_ptr(const Unit& u) const { return Bt + ((size_t)u.e * nrows + (size_t)u.pn * BM) * ((size_t)KB); }
    __device__ __forceinline__ void gather_issue(const Unit& u, const int (&sR)[2], int (&raw)[2][2]) const {
        const int n = cnt[u.e];
#pragma unroll
        for (int h = 0; h < 2; ++h)
#pragma unroll
            for (int i = 0; i < 2; ++i) { const int idx = u.mt * BM + h * HALF + sR[i]; raw[h][i] = list[u.e * LISTCAP + (idx < n ? idx : n - 1)]; }
    }
    __device__ __forceinline__ void gather_finish(const int (&raw)[2][2], const int (&sC)[2], unsigned (&v)[2][2]) const {
#pragma unroll
        for (int h = 0; h < 2; ++h)
#pragma unroll
            for (int i = 0; i < 2; ++i) v[h][i] = (unsigned)((raw[h][i] >> 2) * KB + sC[i] * 2);
    }
    __device__ __forceinline__ void gather(const Unit& u, const int (&sR)[2], const int (&sC)[2], unsigned (&v)[2][2]) const { int raw[2][2]; gather_issue(u, sR, raw); gather_finish(raw, sC, v); }
};

__device__ __forceinline__ u32x4 pack8(f32x4 a, f32x4 b) { u32x4 w; w.x = cvt_pk_bf16(a[0], a[1]); w.y = cvt_pk_bf16(a[2], a[3]); w.z = cvt_pk_bf16(b[0], b[1]); w.w = cvt_pk_bf16(b[2], b[3]); return w; }

__device__ __forceinline__ float clamp448(float v) { return fminf(fmaxf(v, -448.0f), 448.0f); }
__device__ __forceinline__ unsigned pack4_fp8(f32x4 a) { int p = 0; p = __builtin_amdgcn_cvt_pk_fp8_f32(clamp448(a[0]), clamp448(a[1]), p, false); p = __builtin_amdgcn_cvt_pk_fp8_f32(clamp448(a[2]), clamp448(a[3]), p, true); return (unsigned)p; }
__device__ __forceinline__ unsigned pack4_fp8_nc(f32x4 a) { int p = 0; p = __builtin_amdgcn_cvt_pk_fp8_f32(a[0], a[1], p, false); p = __builtin_amdgcn_cvt_pk_fp8_f32(a[2], a[3], p, true); return (unsigned)p; }
constexpr float WSCALE = 32.0f, WINV = 1.0f / 32.0f;

struct EpiInProj {
    static constexpr bool HAS_MID = false, META = false;
    bf16_t* obase; const float* qg; const float* kg; float* ssq_gv;
    __device__ __forceinline__ void mid(f32x4 (&)[2][2][4][2], const Unit&, int, int, int, int) const {}
    __device__ __forceinline__ void operator()(const f32x4 (&acc)[2][2][4][2], const Unit& u, int wr, int wc, int fr, int fq) const {
        const int kind = u.pn >> 1;
        bf16_t* O = obase + (size_t)kind * QSTRIDE;
        const int col0 = (u.pn & 1) * 256 + wc * 64 + 8 * fq;
        const int row0 = u.pm * BM + wr * 64 + fr;
        if (kind <= 1) {
            const float* g = kind == 0 ? qg : kg; const float sc = kind == 0 ? C2 : 1.0f;
            f32x4 gv[2][2];
#pragma unroll
            for (int bj = 0; bj < 2; ++bj)
#pragma unroll
                for (int n = 0; n < 2; ++n) gv[bj][n] = *(const f32x4*)(g + 32 * bj + 8 * fq + 4 * n) * sc;
#pragma unroll
            for (int ai = 0; ai < 2; ++ai)
#pragma unroll
                for (int m = 0; m < 4; ++m) {
                    float ss = 0.f;
#pragma unroll
                    for (int bj = 0; bj < 2; ++bj)
#pragma unroll
                        for (int n = 0; n < 2; ++n) { const f32x4 x = acc[ai][bj][m][n]; ss += (x[0] * x[0] + x[1] * x[1]) + (x[2] * x[2] + x[3] * x[3]); }
                    ss += __shfl_xor(ss, 16); ss += __shfl_xor(ss, 32);
                    const float rs = __builtin_amdgcn_rsqf(ss * (1.0f / 64.0f) + EPS);
                    bf16_t* rowp = O + (size_t)(row0 + ai * HALF + m * 16) * 512 + col0;
#pragma unroll
                    for (int bj = 0; bj < 2; ++bj) *(u32x4*)(rowp + 32 * bj) = pack8(acc[ai][bj][m][0] * rs * gv[bj][0], acc[ai][bj][m][1] * rs * gv[bj][1]);
                }
        } else if (kind == 2) {
#pragma unroll
            for (int ai = 0; ai < 2; ++ai)
#pragma unroll
                for (int m = 0; m < 4; ++m) { bf16_t* rowp = O + (size_t)(row0 + ai * HALF + m * 16) * 512 + col0;
#pragma unroll
                    for (int bj = 0; bj < 2; ++bj) *(u32x4*)(rowp + 32 * bj) = pack8(acc[ai][bj][m][0], acc[ai][bj][m][1]); }
        } else if (kind == 3) {
#pragma unroll
            for (int ai = 0; ai < 2; ++ai)
#pragma unroll
                for (int m = 0; m < 4; ++m) { bf16_t* rowp = O + (size_t)(row0 + ai * HALF + m * 16) * 512 + col0;
#pragma unroll
                    for (int bj = 0; bj < 2; ++bj) *(u32x4*)(rowp + 32 * bj) = pack8(gelu4(acc[ai][bj][m][0]), gelu4(acc[ai][bj][m][1])); }
        } else {
#pragma unroll
            for (int ai = 0; ai < 2; ++ai)
#pragma unroll
                for (int m = 0; m < 4; ++m) { const int row = row0 + ai * HALF + m * 16; bf16_t* rowp = O + (size_t)row * 512 + col0; float ss = 0.f;
#pragma unroll
                    for (int bj = 0; bj < 2; ++bj) { const f32x4 a = gelu4(acc[ai][bj][m][0]), b = gelu4(acc[ai][bj][m][1]);
                        ss += (a[0] * a[0] + a[1] * a[1]) + (a[2] * a[2] + a[3] * a[3]) + (b[0] * b[0] + b[1] * b[1]) + (b[2] * b[2] + b[3] * b[3]);
                        *(u32x4*)(rowp + 32 * bj) = pack8(a, b); }
                    ss += __shfl_xor(ss, 16); ss += __shfl_xor(ss, 32);
                    if (fq == 0) ssq_gv[(size_t)row * 8 + (u.pn & 1) * 4 + wc] = ss; }
        }
    }
};

struct EpiOutProj {
    static constexpr bool HAS_MID = true, META = false;
    bf16_t* mo; const float* ssq_att; const float* x;
    __device__ __forceinline__ void mid(f32x4 (&acc)[2][2][4][2], const Unit& u, int wr, int wc, int fr, int fq) const {
#pragma unroll
        for (int ai = 0; ai < 2; ++ai)
#pragma unroll
            for (int m = 0; m < 4; ++m) { const int row = u.pm * BM + ai * HALF + wr * 64 + m * 16 + fr;
                const f32x4 a = *(const f32x4*)(ssq_att + (size_t)row * 8), b = *(const f32x4*)(ssq_att + (size_t)row * 8 + 4);
                const float s = ((a[0] + a[1]) + (a[2] + a[3])) + ((b[0] + b[1]) + (b[2] + b[3]));
                const float rs = __builtin_amdgcn_rsqf(s * (1.0f / 512.0f) + EPS);
#pragma unroll
                for (int bj = 0; bj < 2; ++bj)
#pragma unroll
                    for (int n = 0; n < 2; ++n) acc[ai][bj][m][n] *= rs; }
    }
    __device__ __forceinline__ void operator()(const f32x4 (&acc)[2][2][4][2], const Unit& u, int wr, int wc, int fr, int fq) const {
        f32x4 xr[4][2][2];
#define OP_XLOAD(c) do { const float* xp_ = x + (size_t)(u.pm * BM + ((c) >> 2) * HALF + wr * 64 + ((c) & 3) * 16 + fr) * D + u.pn * BM + wc * 64 + 8 * fq; \
            _Pragma("unroll") for (int bj = 0; bj < 2; ++bj) { xr[(c) & 3][bj][0] = __builtin_nontemporal_load((const f32x4*)(xp_ + 32 * bj)); xr[(c) & 3][bj][1] = __builtin_nontemporal_load((const f32x4*)(xp_ + 32 * bj + 4)); } } while (0)
        OP_XLOAD(0); OP_XLOAD(1); OP_XLOAD(2); OP_XLOAD(3);
#pragma unroll
        for (int c = 0; c < 8; ++c) { const int ai = c >> 2, m = c & 3;
            bf16_t* rowp = mo + (size_t)(u.pm * BM + ai * HALF + wr * 64 + m * 16 + fr) * D + u.pn * BM + wc * 64 + 8 * fq;
#pragma unroll
            for (int bj = 0; bj < 2; ++bj) *(u32x4*)(rowp + 32 * bj) = pack8(acc[ai][bj][m][0] + xr[c & 3][bj][0], acc[ai][bj][m][1] + xr[c & 3][bj][1]);
            if (c + 4 < 8) { asm volatile("" ::: "memory"); OP_XLOAD(c + 4); }
        }
#undef OP_XLOAD
    }
};

struct EpiSwiglu {
    static constexpr bool HAS_MID = false, META = true;
    bf16_t* act; const float* b_in;
    __device__ __forceinline__ void mid(f32x4 (&)[2][2][4][2], const Unit&, int, int, int, int) const {}
    __device__ __forceinline__ unsigned meta_issue(const Unit& u, int tid) const {
        const int t = tid & 255; return __builtin_bit_cast(unsigned, b_in[(size_t)u.e * 2048 + (t >> 7) * 1024 + u.pn * 128 + (t & 127)] + (float)(t >> 7));
    }
    __device__ __forceinline__ void meta_finish(unsigned bits, LAS unsigned char* buf, int tid) const { if (tid < 256) ((LAS unsigned*)buf)[tid] = bits; }
    __device__ __forceinline__ void run(const f32x4 (&acc)[2][2][4][2], const Unit& u, int wr, int wc, int fr, int fq, const LAS unsigned char* buf) const {
        const int cl = wc * 32 + 8 * fq, col = u.pn * 128 + cl;
        f32x4 bg[2], bl[2];
#pragma unroll
        for (int n = 0; n < 2; ++n) { bg[n] = *(const LAS f32x4*)(buf + (cl + 4 * n) * 4); bl[n] = *(const LAS f32x4*)(buf + (128 + cl + 4 * n) * 4); }
#pragma unroll
        for (int ai = 0; ai < 2; ++ai)
#pragma unroll
            for (int m = 0; m < 4; ++m) { const size_t row = (size_t)u.pm * BM + ai * HALF + wr * 64 + m * 16 + fr; f32x4 o[2];
#pragma unroll
                for (int n = 0; n < 2; ++n)
#pragma unroll
                    for (int hh = 0; hh < 2; ++hh) {
                        const f32x2 ag = {acc[ai][0][m][n][2 * hh], acc[ai][0][m][n][2 * hh + 1]}, al = {acc[ai][1][m][n][2 * hh], acc[ai][1][m][n][2 * hh + 1]};
                        f32x2 g = ag * WINV + (f32x2){bg[n][2 * hh], bg[n][2 * hh + 1]}; g.x = fminf(g.x, 7.0f); g.y = fminf(g.y, 7.0f);
                        f32x2 l = al * WINV + (f32x2){bl[n][2 * hh], bl[n][2 * hh + 1]};
                        l.x = __builtin_amdgcn_fmed3f(l.x, -6.0f, 8.0f); l.y = __builtin_amdgcn_fmed3f(l.y, -6.0f, 8.0f);
                        const f32x2 t = g * (-1.702f * LOG2E); f32x2 e; e.x = __builtin_amdgcn_exp2f(t.x); e.y = __builtin_amdgcn_exp2f(t.y);
                        const f32x2 d = e + 1.0f; f32x2 sg; sg.x = __builtin_amdgcn_rcpf(d.x); sg.y = __builtin_amdgcn_rcpf(d.y);
                        const f32x2 r = (g * sg) * l; o[n][2 * hh] = r.x; o[n][2 * hh + 1] = r.y; }
                u32x2 w; w.x = pack4_fp8_nc(o[0]); w.y = pack4_fp8_nc(o[1]); *(u32x2*)((unsigned char*)act + row * DE + col) = w; }
    }
};

struct EpiDown {
    static constexpr bool HAS_MID = false, META = true;
    unsigned char* y; const float* b_out; const int* list; const LAS int* cnt;
    __device__ __forceinline__ void mid(f32x4 (&)[2][2][4][2], const Unit&, int, int, int, int) const {}
    __device__ __forceinline__ unsigned meta_issue(const Unit& u, int tid) const {
        if (tid < 256) return __builtin_bit_cast(unsigned, b_out[(size_t)u.e * D + u.pn * BM + tid]);
        const int nv = cnt[u.e] - u.mt * BM, r = tid - 256; return (unsigned)list[u.e * LISTCAP + u.mt * BM + (r < nv ? r : 0)];
    }
    __device__ __forceinline__ void meta_finish(unsigned bits, LAS unsigned char* buf, int tid) const { ((LAS unsigned*)buf)[tid] = bits; }
    __device__ __forceinline__ void run(const f32x4 (&acc)[2][2][4][2], const Unit& u, int wr, int wc, int fr, int fq, const LAS unsigned char* buf) const {
        const int cl = wc * 64 + 16 * fq, col = u.pn * BM + cl; const int nvalid = cnt[u.e] - u.mt * BM;
        f32x4 bv[2][2];
#pragma unroll
        for (int bj = 0; bj < 2; ++bj)
#pragma unroll
            for (int n = 0; n < 2; ++n) bv[bj][n] = *(const LAS f32x4*)(buf + (cl + 8 * bj + 4 * n) * 4);
#pragma unroll
        for (int ai = 0; ai < 2; ++ai) { if (ai == 1 && u.hs >= 0) break;
#pragma unroll
            for (int m = 0; m < 4; ++m) { const int rl = ai * HALF + (u.hs > 0 ? HALF : 0) + wr * 64 + m * 16 + fr; const int aid = ((const LAS int*)buf)[256 + rl]; u32x4 w;
#pragma unroll
                for (int bj = 0; bj < 2; ++bj)
#pragma unroll
                    for (int n = 0; n < 2; ++n) w[2 * bj + n] = pack4_fp8(acc[ai][bj][m][n] * WINV + bv[bj][n]);
                if (rl < nvalid) *(u32x4*)(y + (size_t)aid * D + col) = w; } }
    }
};
}

struct XItem { const float* src; unsigned char* dst; };
__device__ __forceinline__ XItem xitem_decode(int r, const float* we1, unsigned char* W1, int lane) {
    const int kr = lane >> 3, n4 = lane & 7; const int e = r >> 9, q = r & 511, kb = q >> 6, nb = q & 63; const int n0 = 32 * nb, bj = n0 >> 10, j0 = n0 & 1023;
    const int drow = 256 * (j0 >> 7) + 64 * ((j0 >> 5) & 3) + 32 * bj; XItem d;
    d.src = we1 + (size_t)e * D * 2048 + (size_t)(128 * kb + 16 * kr) * 2048 + n0 + 4 * n4; d.dst = W1 + (size_t)e * 2048 * D + (size_t)(drow + 4 * n4) * D + 128 * kb + 16 * kr; return d;
}
__device__ __forceinline__ void xitem_load(const XItem& d, f32x4 (&v)[16]) {
#pragma unroll
    for (int i = 0; i < 16; ++i) v[i] = __builtin_nontemporal_load((const f32x4*)(d.src + (size_t)i * 2048));
}
__device__ __forceinline__ void xitem_store(const XItem& d, const f32x4 (&v)[16]) {
#pragma unroll
    for (int nn = 0; nn < 4; ++nn) { u32x4 o;
#pragma unroll
        for (int q = 0; q < 4; ++q) o[q] = pg8::pack4_fp8((f32x4){v[4 * q][nn], v[4 * q + 1][nn], v[4 * q + 2][nn], v[4 * q + 3][nn]} * pg8::WSCALE);
        __builtin_nontemporal_store(o, (u32x4*)(d.dst + (size_t)nn * D)); }
}

namespace att {
constexpr int NSLOT = 7, LEAD = NSLOT - 4, L_K = 0, L_V = NSLOT * 8192, L_TAB = 2 * NSLOT * 8192, L_WS = L_TAB + 2048, L_OST = L_WS + 2048, OST_STRIDE = 68, OST_BYTES = 16 * OST_STRIDE * 4;
__device__ __forceinline__ int crow(int r, int hi) { return (r & 3) + 8 * (r >> 2) + 4 * hi; }
__device__ __forceinline__ s16x4 vtr(const LAS char* p) { typedef short v4i16_t __attribute__((ext_vector_type(4))); return __builtin_bit_cast(s16x4, __builtin_amdgcn_ds_read_tr16_b64_v4i16((LAS v4i16_t*)p)); }

template <bool FULL>
__device__ __forceinline__ void attn_units(int b0, int bstep, int nunits, int h, int qb, const bf16_t* Q, const bf16_t* Kt, const bf16_t* Vt, bf16_t* MIX, float* ssq_att,
                                           const float* rel_bias, const float* MH, const float* g_att, LAS unsigned char* lds) {
    const int tid = opaque_tid(), lane = tid & 63, r32 = lane & 31, hi = lane >> 5; const int wid = __builtin_amdgcn_readfirstlane(tid >> 6);
    const int q0 = qb * 256;
    LAS float* dt = (LAS float*)(lds + L_TAB);
    const float mh = MH[h], bfar = rel_bias[h * 257 + 256];
    if (tid < 320) dt[319 - tid] = (rel_bias[h * 257 + (tid < 256 ? tid : 256)] - bfar) * LOG2E;
    const int base = 4 * qb - 8, o = wid >> 1, qo = 32 * (wid & 1);
    const int i0 = FULL ? 0 : (base + 3 < 0 ? -(base + 3) : 0);
    constexpr int NPK = FULL ? 4 + LEAD : 4, NPV = FULL ? 3 + LEAD : 4;
    const int ch = lane & 7;
    const f32x4 g0 = *(const f32x4*)(g_att + h * 64 + ch * 8), g1 = *(const f32x4*)(g_att + h * 64 + ch * 8 + 4);
    const bf16_t* Qw = Q + ((size_t)b0 * SEQ + q0 + wid * 32 + r32) * 512 + h * 64 + hi * 8;
    bf16x8 qr[4];
#pragma unroll
    for (int d0 = 0; d0 < 4; ++d0) qr[d0] = *(const bf16x8*)(Qw + d0 * 16);
    const bf16_t* ksrc = Kt + ((size_t)b0 * SEQ + lane) * 512 + h * 64 + wid * 8;
    const bf16_t* vsrc = Vt + ((size_t)b0 * SEQ + 16 * (wid & 3) + (lane >> 2)) * 512 + h * 64 + (wid >> 2) * 32 + (lane & 3) * 8;
    const size_t ustride = (size_t)bstep * SEQ * 512;
#define ATT_DMA_K(kp, t) do { const int sl_ = ((t) - base) % NSLOT; glds16((kp) + (size_t)(t) * 64 * 512, (unsigned)__builtin_amdgcn_readfirstlane(lds_addr(lds + L_K + sl_ * 8192 + wid * 1024))); } while (0)
#define ATT_DMA_V(vp_, t) do { const int sl_ = ((t) - base) % NSLOT; glds16((vp_) + (size_t)(t) * 64 * 512, (unsigned)__builtin_amdgcn_readfirstlane(lds_addr(lds + L_V + sl_ * 8192 + wid * 1024))); } while (0)
#define ATT_PROLOGUE(kp, vp_) do { _Pragma("unroll") for (int j = 0; j < NPK; ++j) { const int t = base + i0 + j; if (t >= 0 && t <= base + 11) ATT_DMA_K(kp, t); if (j < NPV && t >= 0) ATT_DMA_V(vp_, t); } } while (0)
    f32x16 cfv;
    { const float cfar = (bfar - mh) * LOG2E;
#pragma unroll
      for (int r = 0; r < 16; ++r) cfv[r] = cfar; }
#define ATT_QK(S0, S1, sl) do { const LAS char* kb = (const LAS char*)(lds + L_K + (sl) * 8192 + hi * 1024 + r32 * 16); \
        _Pragma("unroll") for (int d0 = 0; d0 < 4; ++d0) { \
            const bf16x8 k0 = *(const LAS bf16x8*)(kb + d0 * 2048), k1 = *(const LAS bf16x8*)(kb + d0 * 2048 + 512); \
            S0 = __builtin_amdgcn_mfma_f32_32x32x16_bf16(k0, qr[d0], d0 == 0 ? cfv : S0, 0, 0, 0); \
            S1 = __builtin_amdgcn_mfma_f32_32x32x16_bf16(k1, qr[d0], d0 == 0 ? cfv : S1, 0, 0, 0); } } while (0)
#define ATT_BIAS(S0, S1, delta) do { const int R0 = 319 - (64 * (delta) + qo + r32 + 128 - 4 * hi); \
        _Pragma("unroll") for (int r = 0; r < 16; ++r) { S0[r] += dt[R0 + (r & 3) + 8 * (r >> 2)]; S1[r] += dt[R0 + 32 + (r & 3) + 8 * (r >> 2)]; } } while (0)
#define ATT_SPV(S0, S1, sl) do { float sacc = 0.f; \
        _Pragma("unroll") for (int r = 0; r < 16; ++r) { S0[r] = __builtin_amdgcn_exp2f(S0[r]); S1[r] = __builtin_amdgcn_exp2f(S1[r]); sacc += S0[r] + S1[r]; } \
        l_reg += sacc; \
        u32x4 pw[4]; \
        _Pragma("unroll") for (int j = 0; j < 4; ++j) { pw[0][j] = cvt_pk_bf16(S0[2 * j], S0[2 * j + 1]); pw[1][j] = cvt_pk_bf16(S0[8 + 2 * j], S0[8 + 2 * j + 1]); \
                                                         pw[2][j] = cvt_pk_bf16(S1[2 * j], S1[2 * j + 1]); pw[3][j] = cvt_pk_bf16(S1[8 + 2 * j], S1[8 + 2 * j + 1]); } \
        const LAS char* vp = (const LAS char*)(lds + L_V + (sl) * 8192 + ((lane >> 4) & 1) * 32 + (lane & 3) * 8 + (4 * hi + ((lane & 15) >> 2)) * 64); \
        _Pragma("unroll") for (int ks = 0; ks < 4; ++ks) { \
            const s16x4 l0 = vtr(vp + ks * 1024), h0 = vtr(vp + ks * 1024 + 512), l1 = vtr(vp + 4096 + ks * 1024), h1 = vtr(vp + 4096 + ks * 1024 + 512); \
            const bf16x8 v0 = (bf16x8){l0[0], l0[1], l0[2], l0[3], h0[0], h0[1], h0[2], h0[3]}, v1 = (bf16x8){l1[0], l1[1], l1[2], l1[3], h1[0], h1[1], h1[2], h1[3]}; \
            const bf16x8 pa = __builtin_bit_cast(bf16x8, pw[ks]); \
            o0 = __builtin_amdgcn_mfma_f32_32x32x16_bf16(pa, v0, o0, 0, 0, 0); \
            o1 = __builtin_amdgcn_mfma_f32_32x32x16_bf16(pa, v1, o1, 0, 0, 0); } } while (0)
    ATT_PROLOGUE(ksrc, vsrc);
#pragma unroll 1
    for (int u = 0; u < nunits; ++u) {
    const bool has_next = u + 1 < nunits;
    const size_t rowbase = (size_t)(b0 + bstep * u) * SEQ;
    f32x16 o0 = {}, o1 = {}; float l_reg = 0.f;
    if constexpr (FULL) {
        static_assert(LEAD == 3, "the counted waits below are written for a lead of 3 steps");
#define ATT_TOP(i, W) do { asm volatile("s_waitcnt vmcnt(" #W ")" ::: "memory"); __syncthreads(); \
        if ((i) + 4 + LEAD <= 11) ATT_DMA_K(ksrc, base + (i) + 4 + LEAD); if ((i) + 3 + LEAD <= 11) ATT_DMA_V(vsrc, base + (i) + 3 + LEAD); } while (0)
#define ATT_BODY(i, C0, C1, N0, N1) do { \
        if ((i) >= 6) ATT_BIAS(C0, C1, 8 - (i)); \
        ATT_QK(N0, N1, ((i) + 1 + o) % NSLOT); ATT_SPV(C0, C1, ((i) + o) % NSLOT); } while (0)
        f32x16 sa0, sa1, sb0, sb1;
        asm volatile("s_waitcnt vmcnt(4)" ::: "memory");
        __syncthreads();
        ATT_QK(sa0, sa1, o);
#pragma unroll 1
        for (int i = 0; i < 8; i += 2) {
            if (i == 6) ATT_TOP(i, 3); else ATT_TOP(i, 4);
            ATT_BODY(i, sa0, sa1, sb0, sb1);
            if (i == 6) ATT_TOP(i + 1, 1); else ATT_TOP(i + 1, 4);
            ATT_BODY(i + 1, sb0, sb1, sa0, sa1);
        }
        ATT_TOP(8, 0);
        if (has_next) {
#pragma unroll
            for (int d0 = 0; d0 < 4; ++d0) qr[d0] = *(const bf16x8*)(Qw + ustride + d0 * 16); }
        ATT_BIAS(sa0, sa1, 0);
        ATT_SPV(sa0, sa1, (8 + o) % NSLOT);
#undef ATT_BODY
#undef ATT_TOP
    } else {
#pragma unroll 1
        for (int i = i0; i <= 8; ++i) {
            VM_WAIT();
            __syncthreads();
            if (i < 8) { ATT_DMA_K(ksrc, base + i + 4); ATT_DMA_V(vsrc, base + i + 4); }
            if (base + i + o >= 0) {
                const int slot = (i + o) % NSLOT;
                f32x16 p0, p1;
                ATT_QK(p0, p1, slot);
                if (i >= 6) ATT_BIAS(p0, p1, 8 - i);
                ATT_SPV(p0, p1, slot);
            }
        }
        if (has_next) {
#pragma unroll
            for (int d0 = 0; d0 < 4; ++d0) qr[d0] = *(const bf16x8*)(Qw + ustride + d0 * 16); }
    }
    __syncthreads();
    Qw += ustride; ksrc += ustride; vsrc += ustride;
    if (has_next) ATT_PROLOGUE(ksrc, vsrc);
#undef ATT_DMA_K
#undef ATT_DMA_V
#undef ATT_PROLOGUE
#undef ATT_QK
#undef ATT_BIAS
#undef ATT_SPV
    l_reg += __shfl_xor(l_reg, 32);
    LAS float* wsf = (LAS float*)(lds + L_WS) + wid * 32;
    if (hi == 0) wsf[r32] = l_reg;
    LDS_WAIT();
    LAS float* stg = (LAS float*)(lds + L_OST + wid * OST_BYTES);
#pragma unroll
    for (int p = 0; p < 2; ++p) {
#pragma unroll
        for (int r = 8 * p; r < 8 * p + 8; ++r) { const int orow = crow(r, hi); const float rl = __builtin_amdgcn_rcpf(wsf[orow]);
            stg[(orow - 16 * p) * OST_STRIDE + r32] = o0[r] * rl; stg[(orow - 16 * p) * OST_STRIDE + 32 + r32] = o1[r] * rl; }
        LDS_WAIT();
#pragma unroll
        for (int i = 0; i < 2; ++i) { const int row = i * 8 + (lane >> 3);
            const f32x4 a = *(const LAS f32x4*)(stg + row * OST_STRIDE + ch * 8), bq = *(const LAS f32x4*)(stg + row * OST_STRIDE + ch * 8 + 4);
            float ss = (a[0] * a[0] + a[1] * a[1]) + (a[2] * a[2] + a[3] * a[3]) + (bq[0] * bq[0] + bq[1] * bq[1]) + (bq[2] * bq[2] + bq[3] * bq[3]);
            ss += __shfl_xor(ss, 1); ss += __shfl_xor(ss, 2); ss += __shfl_xor(ss, 4);
            const size_t tok = rowbase + q0 + wid * 32 + 16 * p + row;
            if (ch == 0) ssq_att[tok * 8 + h] = ss;
            *(u32x4*)(MIX + tok * D + h * 64 + ch * 8) = pg8::pack8(a * g0, bq * g1); }
        LDS_WAIT();
    }
    }
    __syncthreads();
}
}

namespace gm {
constexpr int L_RS = 131072, L_BS = 131072 + 2048;
__device__ __forceinline__ void gmlp_unit(int b, int blk, const bf16_t* GU, const bf16_t* GV, const float* ssq_gv, const bf16_t* wsb, const float* b_s, const float* gvn, const float* g_out,
                                          bf16_t* MIX, LAS unsigned char* lds) {
    const int tid = opaque_tid(), lane = tid & 63, r32 = lane & 31, hi = lane >> 5; const int wid = __builtin_amdgcn_readfirstlane(tid >> 6);
    const size_t t0 = (size_t)b * SEQ + (size_t)blk * 128;
    LAS float* bsl = (LAS float*)(lds + L_BS);
    {
        const int js = 16 * wid + (lane >> 2);
        const bf16_t* src = GV + (t0 + js) * 512 + (lane & 3) * 8;
        u32x4 vt[16];
#pragma unroll
        for (int i = 0; i < 16; ++i) vt[i] = *(const u32x4*)(src + i * 32);
        const f32x4 qa = *(const f32x4*)(ssq_gv + (t0 + js) * 8), qb_ = *(const f32x4*)(ssq_gv + (t0 + js) * 8 + 4);
        float rsg[4];
        rsg[0] = __builtin_amdgcn_rsqf((qa[0] + qa[1]) * (1.0f / 128.0f) + EPS); rsg[1] = __builtin_amdgcn_rsqf((qa[2] + qa[3]) * (1.0f / 128.0f) + EPS);
        rsg[2] = __builtin_amdgcn_rsqf((qb_[0] + qb_[1]) * (1.0f / 128.0f) + EPS); rsg[3] = __builtin_amdgcn_rsqf((qb_[2] + qb_[3]) * (1.0f / 128.0f) + EPS);
        bsl[tid] = b_s[tid];
#pragma unroll
        for (int i = 0; i < 16; ++i) { const float r_ = rsg[i >> 2]; u32x4 w_;
#pragma unroll
            for (int k = 0; k < 4; ++k) w_[k] = cvt_pk_bf16(__builtin_bit_cast(float, vt[i][k] << 16) * r_, __builtin_bit_cast(float, vt[i][k] & 0xffff0000u) * r_);
            *(LAS u32x4*)(lds + i * 8192 + wid * 1024 + lane * 16) = w_; }
    }
    __syncthreads();
    const int g = wid >> 1, chh = wid & 1;
    f32x16 acc[4][2];
#pragma unroll
    for (int ib = 0; ib < 4; ++ib) { acc[ib][0] = (f32x16){}; acc[ib][1] = (f32x16){}; }
    const LAS char* vp = (const LAS char*)(lds + (g * 4 + 2 * chh) * 8192 + ((lane >> 4) & 1) * 32 + (lane & 3) * 8 + (4 * hi + ((lane & 15) >> 2)) * 64);
    const u32x4* wp = (const u32x4*)(wsb + ((size_t)(g * 128 + r32) * 128 + 8 * hi));
    u32x4 wf[8][4];
#define GM_WLOAD(s_) do { _Pragma("unroll") for (int ib = 0; ib < 4; ++ib) { if (ib < 2 && (s_) >= 4) continue; wf[s_][ib] = wp[(32 * ib * 128 + 16 * (s_)) / 8]; } } while (0)
    GM_WLOAD(0); GM_WLOAD(1);
#pragma unroll
    for (int s = 0; s < 8; ++s) {
        if (s + 2 < 8) GM_WLOAD(s + 2);
        const s16x4 l0 = att::vtr(vp + s * 1024), h0 = att::vtr(vp + s * 1024 + 512), l1 = att::vtr(vp + 8192 + s * 1024), h1 = att::vtr(vp + 8192 + s * 1024 + 512);
        const bf16x8 v0 = (bf16x8){l0[0], l0[1], l0[2], l0[3], h0[0], h0[1], h0[2], h0[3]}, v1 = (bf16x8){l1[0], l1[1], l1[2], l1[3], h1[0], h1[1], h1[2], h1[3]};
#pragma unroll
        for (int ib = 0; ib < 4; ++ib) {
            if (ib < 2 && s >= 4) continue;
            const bf16x8 af = __builtin_bit_cast(bf16x8, wf[s][ib]);
            acc[ib][0] = __builtin_amdgcn_mfma_f32_32x32x16_bf16(af, v0, acc[ib][0], 0, 0, 0);
            acc[ib][1] = __builtin_amdgcn_mfma_f32_32x32x16_bf16(af, v1, acc[ib][1], 0, 0, 0);
        }
        asm volatile("" ::: "memory");
    }
#undef GM_WLOAD
    u32x4 uu[16];
#pragma unroll
    for (int rr = 0; rr < 16; ++rr) uu[rr] = *(const u32x4*)(GU + (t0 + 16 * wid + rr) * 512 + 8 * lane);
    __syncthreads();
    {
        const float gn0 = gvn[g * 128 + 64 * chh + r32], gn1 = gvn[g * 128 + 64 * chh + 32 + r32];
        LAS bf16_t* stg = (LAS bf16_t*)lds;
#pragma unroll
        for (int ib = 0; ib < 4; ++ib)
#pragma unroll
            for (int r = 0; r < 16; ++r) { const int i = 32 * ib + att::crow(r, hi); const float bb = bsl[g * 128 + i];
                const unsigned pk = cvt_pk_bf16(acc[ib][0][r] * gn0 + bb, acc[ib][1][r] * gn1 + bb);
                stg[i * 512 + g * 128 + 64 * chh + r32] = (bf16_t)(pk & 0xffffu); stg[i * 512 + g * 128 + 64 * chh + 32 + r32] = (bf16_t)(pk >> 16); }
    }
    __syncthreads();
    {
        const f32x4 go0 = *(const f32x4*)(g_out + 8 * lane), go1 = *(const f32x4*)(g_out + 8 * lane + 4);
#pragma unroll
        for (int rr = 0; rr < 16; ++rr) { const int i = 16 * wid + rr;
            const u32x4 gt = *(const LAS u32x4*)(lds + (size_t)i * 1024 + lane * 16);
            float v[8];
#pragma unroll
            for (int k = 0; k < 4; ++k) { v[2 * k] = __builtin_bit_cast(float, gt[k] << 16) * __builtin_bit_cast(float, uu[rr][k] << 16);
                                           v[2 * k + 1] = __builtin_bit_cast(float, gt[k] & 0xffff0000u) * __builtin_bit_cast(float, uu[rr][k] & 0xffff0000u); }
            float ss = 0.f;
#pragma unroll
            for (int k = 0; k < 8; ++k) ss += v[k] * v[k];
            ss = wave_sum(ss);
            const float rs = __builtin_amdgcn_rsqf(ss * (1.0f / 512.0f) + EPS);
            const f32x4 a = (f32x4){v[0], v[1], v[2], v[3]} * rs * go0, c = (f32x4){v[4], v[5], v[6], v[7]} * rs * go1;
            *(u32x4*)(MIX + (t0 + i) * D + 512 + 8 * lane) = pg8::pack8(a, c); }
    }
    __syncthreads();
}
}

#define XB_TMO      128
#define XB_XCNT(j)  (256  + 64 * (j))
#define XB_XSUB(j)  (1280 + 64 * (j))
#define XB_XGEN(j)  (2304 + 64 * (j))
#define XB_TOP      3328
#define XB_TOPGEN   3392
#define XCD_BAR_WORDS 3456
#define XB_SPIN_CAP (1u << 18)
__device__ __forceinline__ unsigned xb_ld(unsigned* p)              { return __hip_atomic_load(p, __ATOMIC_RELAXED, __HIP_MEMORY_SCOPE_AGENT); }
__device__ __forceinline__ unsigned xb_add(unsigned* p, unsigned v) { return __hip_atomic_fetch_add(p, v, __ATOMIC_RELAXED, __HIP_MEMORY_SCOPE_AGENT); }
__device__ __forceinline__ unsigned xb_xcc_id() { return (unsigned)__builtin_amdgcn_s_getreg((3 << 11) | 20) & 0xFu; }
#define XB_SPIN(cond, bar) do { unsigned _sp = 0; while (cond) { __builtin_amdgcn_s_sleep(1); \
    if ((++_sp & 255u) == 0u) { if (xb_ld(&(bar)[XB_TMO])) break; if (_sp > XB_SPIN_CAP) { atomicAdd(&(bar)[XB_TMO], 1u); break; } } } } while (0)
struct XcdBarrier { unsigned* bar; unsigned x; volatile LAS unsigned* st; };
__device__ __forceinline__ XcdBarrier xcd_barrier_post(unsigned* bar, volatile LAS unsigned* st) {
    XcdBarrier b; b.bar = bar; b.x = xb_xcc_id(); b.st = st;
    if (threadIdx.x == 0) (void)xb_add(&bar[XB_XCNT(b.x)], 1u);
    return b;
}
__device__ __forceinline__ void xcd_barrier_complete(unsigned* bar, unsigned x, unsigned& nloc, unsigned& nx) {
    const unsigned G = gridDim.x * gridDim.y * gridDim.z;
    unsigned sum, cnt, mine, sp = 0u;
    for (;;) {
        sum = 0u; cnt = 0u; mine = 0u;
#pragma unroll
        for (unsigned j = 0; j < 16; ++j) { const unsigned c = xb_ld(&bar[XB_XCNT(j)]); sum += c; cnt += (c > 0u) ? 1u : 0u; mine = (j == x) ? c : mine; }
        if (sum == G) break;
        __builtin_amdgcn_s_sleep(1);
        if ((++sp & 255u) == 0u) { if (xb_ld(&bar[XB_TMO])) break; if (sp > XB_SPIN_CAP) { atomicAdd(&bar[XB_TMO], 1u); break; } }
    }
    nloc = mine > 0u ? mine : 1u; nx = cnt > 0u ? cnt : 1u;
}
__device__ __forceinline__ void xcd_barrier(const XcdBarrier& b) {
    asm volatile("s_waitcnt vmcnt(0)" ::: "memory");
    __syncthreads();
    if (threadIdx.x == 0) {
        unsigned* bar = b.bar;
        __builtin_amdgcn_s_waitcnt(0);
        unsigned nloc = b.st[0], nx = b.st[1];
        if (nloc == 0u) { xcd_barrier_complete(bar, b.x, nloc, nx); b.st[0] = nloc; b.st[1] = nx; }
        const unsigned old = xb_add(&bar[XB_XSUB(b.x)], 1u);
        const unsigned gen = old / nloc;
        if (old + 1u == (gen + 1u) * nloc) {
            __builtin_amdgcn_fence(__ATOMIC_RELEASE, "agent");
            asm volatile("s_waitcnt vmcnt(0)" ::: "memory");
            const unsigned og = xb_add(&bar[XB_TOP], 1u);
            const unsigned tg = og / nx;
            if (og + 1u == (tg + 1u) * nx) xb_add(&bar[XB_TOPGEN], 1u);
            else XB_SPIN(xb_ld(&bar[XB_TOPGEN]) == tg, bar);
            __builtin_amdgcn_fence(__ATOMIC_ACQUIRE, "agent");
            xb_add(&bar[XB_XGEN(b.x)], 1u);
            asm volatile("s_waitcnt vmcnt(0)" ::: "memory");
        } else {
            XB_SPIN(xb_ld(&bar[XB_XGEN(b.x)]) == gen, bar);
            __builtin_amdgcn_fence(__ATOMIC_ACQUIRE, "agent");
            asm volatile("s_waitcnt vmcnt(0)" ::: "memory");
        }
    }
    __syncthreads();
}

struct Args { const float* in[19]; float* out; unsigned char* ws; int ph_lo, ph_hi; };
enum { I_X = 0, I_GMIX, I_WIN, I_QG, I_KG, I_RELB, I_GVN, I_WS, I_BS, I_GATT, I_GGM, I_WOUT, I_GMOE, I_WR, I_BR, I_WE1, I_BE1, I_WE2, I_BE2 };

template <int KT, bool FP8OUT>
__device__ __forceinline__ void transpose_item(const float* W, int K, int N, void* WT, int dst_row0, int k0, int n0, float scale, int lane) {
    constexpr int KL = KT / 8;
    static_assert((FP8OUT && KL == 16) || (!FP8OUT && KL == 8), "16 bytes per lane and column");
    f32x4 v[KL];
    const int kr = lane >> 3, n4 = lane & 7;
    const float* src = W + (size_t)(k0 + KL * kr) * N + n0 + 4 * n4;
#pragma unroll
    for (int i = 0; i < KL; ++i) v[i] = __builtin_nontemporal_load((const f32x4*)(src + (size_t)i * N));
#pragma unroll
    for (int nn = 0; nn < 4; ++nn) {
        u32x4 o;
        if constexpr (FP8OUT) {
#pragma unroll
            for (int q = 0; q < 4; ++q) o[q] = pg8::pack4_fp8((f32x4){v[4 * q][nn], v[4 * q + 1][nn], v[4 * q + 2][nn], v[4 * q + 3][nn]} * scale);
            __builtin_nontemporal_store(o, (u32x4*)((unsigned char*)WT + (size_t)(dst_row0 + 4 * n4 + nn) * K + k0 + 16 * kr));
        } else {
#pragma unroll
            for (int q = 0; q < 4; ++q) o[q] = cvt_pk_bf16(v[2 * q][nn], v[2 * q + 1][nn]);
            *(u32x4*)((bf16_t*)WT + (size_t)(dst_row0 + 4 * n4 + nn) * K + k0 + 8 * kr) = o;
        }
    }
}

__device__ __forceinline__ void p4_router(LAS unsigned char* lds, const float* x, const bf16_t* MO, bf16_t* HB, float* GATES, int* LIST, unsigned* ECNT,
                                          const float* gmoe, const float* wr, const float* br, int G, int bx, const float* we1, unsigned char* W1c) {
    const int tid = opaque_tid(), lane = tid & 63; const int wid = __builtin_amdgcn_readfirstlane(tid >> 6);
    LAS unsigned short* whi = (LAS unsigned short*)lds; LAS unsigned short* wlo = (LAS unsigned short*)(lds + 32 * 2064);
    LAS float* part = (LAS float*)(lds + 132096);
    LAS int* lcnt = (LAS int*)(lds + LDS_LCNT);
    LAS float* ssqp = (LAS float*)(lds + LDS_LCNT + 256);
    LAS float* rsl = (LAS float*)(lds + LDS_LCNT + 768);
    LAS unsigned short* sel = (LAS unsigned short*)(lds + LDS_PT);
    {
        f32x4 wv[16]; float gk[16];
#pragma unroll
        for (int i = 0; i < 16; ++i) { const int idx4 = tid + 512 * i; wv[i] = *((const f32x4*)wr + idx4); gk[i] = gmoe[idx4 >> 3]; }
#pragma unroll
        for (int i = 0; i < 16; ++i) { const int idx4 = tid + 512 * i, k = idx4 >> 3, e0 = (idx4 & 7) * 4;
#pragma unroll
            for (int c = 0; c < 4; ++c) { const float v = wv[i][c] * gk[i];
                const unsigned hi = cvt_pk_bf16(v, 0.f) & 0xffffu; const float r = v - __builtin_bit_cast(float, hi << 16);
                whi[(e0 + c) * 1032 + k] = (unsigned short)hi; wlo[(e0 + c) * 1032 + k] = (unsigned short)(cvt_pk_bf16(r, 0.f) & 0xffffu); } }
    }
    if (tid < 32) lcnt[tid] = 0;
    __syncthreads();
    const int tt = lane & 15, q = lane >> 4, kb = 128 * wid + 8 * q;
    f32x4 gg[8];
#pragma unroll
    for (int s = 0; s < 4; ++s) { gg[2 * s] = *(const f32x4*)(gmoe + kb + 32 * s); gg[2 * s + 1] = *(const f32x4*)(gmoe + kb + 32 * s + 4); }
    const f32x4 b0 = *(const f32x4*)(br + 4 * q), b1 = *(const f32x4*)(br + 16 + 4 * q);
    const int nr = (T / 16 - bx + G - 1) / G;
    u32x4 ma[4], mb[4];
    XItem xd; f32x4 xw[16];
#define P4_LOAD(jr, MV) do { const size_t ro_ = (size_t)(16 * (bx + (jr) * G) + tt) * D + kb; \
        _Pragma("unroll") for (int s = 0; s < 4; ++s) { MV[s] = __builtin_nontemporal_load((const u32x4*)(MO + ro_ + 32 * s)); } } while (0)
    if (nr > 0) P4_LOAD(0, ma);
    if (nr > 1) P4_LOAD(1, mb);
    if (nr > 0) { xd = xitem_decode(8192 + bx * 8 + wid, we1, W1c, lane); xitem_load(xd, xw); }
#define P4_ROUND(j, MV, ITEM) do { \
        const int tb = 16 * (bx + j * G); \
        f32x4 hv[8]; float ssq = 0.f; \
_Pragma("unroll") \
        for (int s = 0; s < 4; ++s) { \
            hv[2 * s] = (f32x4){__builtin_bit_cast(float, MV[s][0] << 16), __builtin_bit_cast(float, MV[s][0] & 0xffff0000u), __builtin_bit_cast(float, MV[s][1] << 16), __builtin_bit_cast(float, MV[s][1] & 0xffff0000u)}; \
            hv[2 * s + 1] = (f32x4){__builtin_bit_cast(float, MV[s][2] << 16), __builtin_bit_cast(float, MV[s][2] & 0xffff0000u), __builtin_bit_cast(float, MV[s][3] << 16), __builtin_bit_cast(float, MV[s][3] & 0xffff0000u)}; } \
_Pragma("unroll") \
        for (int s = 0; s < 8; ++s) ssq += (hv[s][0] * hv[s][0] + hv[s][1] * hv[s][1]) + (hv[s][2] * hv[s][2] + hv[s][3] * hv[s][3]); \
        if (j + 2 < nr) { const size_t ro = (size_t)(16 * (bx + (j + 2) * G) + tt) * D + kb; \
_Pragma("unroll") \
            for (int s = 0; s < 4; ++s) { MV[s] = __builtin_nontemporal_load((const u32x4*)(MO + ro + 32 * s)); } } \
        f32x4 a0 = {0.f, 0.f, 0.f, 0.f}, a1 = {0.f, 0.f, 0.f, 0.f}; \
        const LAS unsigned char* w0p = (const LAS unsigned char*)whi + tt * 2064 + kb * 2; \
_Pragma("unroll") \
        for (int s = 0; s < 4; ++s) { \
            u32x4 hh, hl; \
_Pragma("unroll") \
            for (int c = 0; c < 2; ++c) \
_Pragma("unroll") \
                for (int d = 0; d < 2; ++d) { const float f0 = hv[2 * s + c][2 * d], f1 = hv[2 * s + c][2 * d + 1]; const unsigned ph = cvt_pk_bf16(f0, f1); \
                    hh[2 * c + d] = ph; hl[2 * c + d] = cvt_pk_bf16(f0 - __builtin_bit_cast(float, ph << 16), f1 - __builtin_bit_cast(float, ph & 0xffff0000u)); } \
            const bf16x8 bh = __builtin_bit_cast(bf16x8, hh), bl = __builtin_bit_cast(bf16x8, hl); \
            const bf16x8 w0h = *(const LAS bf16x8*)(w0p + 64 * s), w1h = *(const LAS bf16x8*)(w0p + 16 * 2064 + 64 * s); \
            const bf16x8 w0l = *(const LAS bf16x8*)(w0p + 32 * 2064 + 64 * s), w1l = *(const LAS bf16x8*)(w0p + 48 * 2064 + 64 * s); \
            a0 = __builtin_amdgcn_mfma_f32_16x16x32_bf16(w0h, bh, a0, 0, 0, 0); a1 = __builtin_amdgcn_mfma_f32_16x16x32_bf16(w1h, bh, a1, 0, 0, 0); \
            a0 = __builtin_amdgcn_mfma_f32_16x16x32_bf16(w0h, bl, a0, 0, 0, 0); a1 = __builtin_amdgcn_mfma_f32_16x16x32_bf16(w1h, bl, a1, 0, 0, 0); \
            a0 = __builtin_amdgcn_mfma_f32_16x16x32_bf16(w0l, bh, a0, 0, 0, 0); a1 = __builtin_amdgcn_mfma_f32_16x16x32_bf16(w1l, bh, a1, 0, 0, 0); \
        } \
        ssq += __shfl_xor(ssq, 16); ssq += __shfl_xor(ssq, 32); \
        if (q == 0) ssqp[wid * 16 + tt] = ssq; \
        if (wid >= 4) { *(LAS f32x4*)(part + (wid - 4) * 512 + lane * 8) = a0; *(LAS f32x4*)(part + (wid - 4) * 512 + lane * 8 + 4) = a1; } \
        __syncthreads(); \
        if (wid < 4) { \
            a0 += *(const LAS f32x4*)(part + wid * 512 + lane * 8); a1 += *(const LAS f32x4*)(part + wid * 512 + lane * 8 + 4); \
            if (wid > 0) { *(LAS f32x4*)(part + wid * 512 + lane * 8) = a0; *(LAS f32x4*)(part + wid * 512 + lane * 8 + 4) = a1; } \
        } \
        __syncthreads(); \
        if (wid == 0) { \
_Pragma("unroll") \
            for (int p = 1; p < 4; ++p) { a0 += *(const LAS f32x4*)(part + p * 512 + lane * 8); a1 += *(const LAS f32x4*)(part + p * 512 + lane * 8 + 4); } \
            float st = 0.f; \
_Pragma("unroll") \
            for (int w = 0; w < 8; ++w) st += ssqp[w * 16 + tt]; \
            const float rs = __builtin_amdgcn_rsqf(st * (1.0f / D) + EPS); \
            if (q == 0) rsl[tt] = rs; \
            LAS float* lg = part + 4 * 512; \
_Pragma("unroll") \
            for (int r = 0; r < 4; ++r) { lg[tt * 33 + 4 * q + r] = a0[r] * rs + b0[r]; lg[tt * 33 + 16 + 4 * q + r] = a1[r] * rs + b1[r]; } \
        } \
        __syncthreads(); \
        { \
            const LAS float* lg = part + 4 * 512; const int half = lane >> 5, tk = 2 * wid + half, ee = lane & 31; \
            float v = lg[tk * 33 + ee]; float tv[4]; int se[4]; \
_Pragma("unroll") \
            for (int p = 0; p < 4; ++p) { \
                float m = v; \
_Pragma("unroll") \
                for (int o = 1; o < 32; o <<= 1) m = fmaxf(m, __shfl_xor(m, o)); \
                const unsigned long long bal = __ballot(v == m); \
                const unsigned hb32 = half ? (unsigned)(bal >> 32) : (unsigned)bal; \
                const int bi = __builtin_ctz(hb32); \
                tv[p] = m; se[p] = bi; if (ee == bi) v = -3.0e38f; \
            } \
            if (ee == 0) { \
                float ex[4], sum = 0.f; \
_Pragma("unroll") \
                for (int p = 0; p < 4; ++p) { ex[p] = __builtin_amdgcn_exp2f((tv[p] - tv[0]) * LOG2E); sum += ex[p]; } \
                const float inv = 1.0f / sum; \
                *(f32x4*)(GATES + (size_t)(tb + tk) * 4) = (f32x4){ex[0] * inv, ex[1] * inv, ex[2] * inv, ex[3] * inv}; \
_Pragma("unroll") \
                for (int p = 0; p < 4; ++p) { const int pos = __hip_atomic_fetch_add(&lcnt[se[p]], 1, __ATOMIC_RELAXED, __HIP_MEMORY_SCOPE_WORKGROUP); sel[(j * 16 + tk) * 4 + p] = (unsigned short)((se[p] << 9) | pos); } \
            } \
        } \
        { \
            const float rr = rsl[tt]; unsigned char* hb = (unsigned char*)HB + (size_t)(tb + tt) * D + kb; \
_Pragma("unroll") \
            for (int s = 0; s < 4; ++s) { u32x2 w; w.x = pg8::pack4_fp8(hv[2 * s] * rr * gg[2 * s]); w.y = pg8::pack4_fp8(hv[2 * s + 1] * rr * gg[2 * s + 1]); *(u32x2*)(hb + 32 * s) = w; } \
        } \
        if (ITEM) { xitem_store(xd, xw); if (j + 2 < nr) { xd = xitem_decode(8192 + ((j >> 1) + 1) * 2048 + bx * 8 + wid, we1, W1c, lane); xitem_load(xd, xw); } } \
    } while (0)
    for (int j = 0; j < nr; j += 2) {
        P4_ROUND(j, ma, true);
        const int j1 = j + 1;
        if (j1 < nr) P4_ROUND(j1, mb, false);
    }
#undef P4_ROUND
#undef P4_LOAD
    __syncthreads();
    if (tid < 32) lcnt[32 + tid] = (int)__hip_atomic_fetch_add(ECNT + tid, (unsigned)lcnt[tid], __ATOMIC_RELAXED, __HIP_MEMORY_SCOPE_AGENT);
    __syncthreads();
    if (tid < nr * 64) { const unsigned sv = sel[tid]; const int e = sv >> 9, pos = sv & 511; const int jr = tid >> 6, tl = (tid >> 2) & 15, kk = tid & 3;
        LIST[e * LISTCAP + lcnt[32 + e] + pos] = (16 * (bx + jr * G) + tl) * 4 + kk; }
    __syncthreads();
}

__global__ void __launch_bounds__(512, 2) fwd_kernel(Args args) {
    extern __shared__ __attribute__((aligned(16))) unsigned char lds_raw[];
    LAS unsigned char* lds = (LAS unsigned char*)lds_raw;
    const int tid = threadIdx.x, lane = tid & 63; const int wid = __builtin_amdgcn_readfirstlane(tid >> 6);
    const int G = gridDim.x, bx = blockIdx.x;
    const int vcu = (G % 8 == 0) ? (bx % 8) * (G / 8) + bx / 8 : bx;
    unsigned char* ws = args.ws;
    unsigned* ctl = (unsigned*)(ws + WS_CTL);
    volatile LAS unsigned* MISC = (volatile LAS unsigned*)(lds + LDS_MISC);
    if (tid < 64) MISC[tid] = 0u;
    __syncthreads();
    XcdBarrier bar; bar.bar = ctl + CW_BAR; bar.x = 0; bar.st = nullptr;
#if !MK_SPLIT
    bar = xcd_barrier_post(ctl + CW_BAR, MISC + 8);
#define GRID_BAR() xcd_barrier(bar)
#else
#define GRID_BAR() do {} while (0)
#endif
    const int lo = args.ph_lo, hi_ph = args.ph_hi;
#define IN(k) (lo <= (k) && (k) < hi_ph)
#define BOTH(k) (IN(k) && IN((k) + 1))
    const float* x = args.in[I_X]; float* out = args.out;
    bf16_t* WIN = (bf16_t*)(ws + WS_WIN); bf16_t* WO = (bf16_t*)(ws + WS_WO); bf16_t* W1 = (bf16_t*)(ws + WS_W1); bf16_t* W2 = (bf16_t*)(ws + WS_W2);
    bf16_t* HB = (bf16_t*)(ws + WS_HB); bf16_t* XB = (bf16_t*)(ws + WS_XB); bf16_t* QB = (bf16_t*)(ws + WS_Q); bf16_t* MIX = (bf16_t*)(ws + WS_MIX);
    bf16_t* ACT = (bf16_t*)(ws + WS_ACT); unsigned char* Y = ws + WS_Y; bf16_t* MO = (bf16_t*)(ws + WS_MO);
    float* SSQGV = (float*)(ws + WS_SSQGV); float* SSQAT = (float*)(ws + WS_SSQAT); float* GATES = (float*)(ws + WS_GATES); float* MHp = (float*)(ws + WS_MH); bf16_t* WSB = (bf16_t*)(ws + WS_WSB);
    int* LIST = (int*)(ws + WS_LIST); unsigned* ECNT = ctl + CW_ECNT;
    const int gw = vcu * 8 + wid, NGW = G * 8;

    if (IN(0)) for (int rep = 0; rep < NREP(0); ++rep) {
        if (rep) GRID_BAR();
        constexpr int I_IN = 16 * 80, I_O = 16 * 32, I_1 = 8 * 64, I_2 = 8 * 32;
        constexpr int NITEMS = I_IN + I_O;
        for (int it = gw; it < NITEMS; it += NGW) {
            int r = it;
            if (r < I_IN) { const int kb = r / 80, nb = r % 80; transpose_item<64, false>(args.in[I_WIN], D, NPROJ, WIN, 32 * nb, 64 * kb, 32 * nb, 1.0f, lane); continue; } r -= I_IN;
            { const int kb = r / 32, nb = r % 32; transpose_item<64, false>(args.in[I_WOUT], D, D, WO, 32 * nb, 64 * kb, 32 * nb, 1.0f, lane); }
        }
        { const float* gmix = args.in[I_GMIX];
          f32x4 gg[4];
#pragma unroll
          for (int j = 0; j < 4; ++j) gg[j] = *(const f32x4*)(gmix + 4 * lane + 256 * j);
          for (int m0 = gw; m0 < T; m0 += 4 * NGW) {
              f32x4 v[4][4]; float ss[4];
#pragma unroll
              for (int r = 0; r < 4; ++r) { const int m = m0 + r * NGW < T ? m0 + r * NGW : m0; const f32x4* xr = (const f32x4*)(x + (size_t)m * D) + lane;
#pragma unroll
                  for (int j = 0; j < 4; ++j) v[r][j] = __builtin_nontemporal_load(xr + 64 * j); }
#pragma unroll
              for (int r = 0; r < 4; ++r) { float s = 0.f;
#pragma unroll
                  for (int j = 0; j < 4; ++j) s += (v[r][j][0] * v[r][j][0] + v[r][j][1] * v[r][j][1]) + (v[r][j][2] * v[r][j][2] + v[r][j][3] * v[r][j][3]);
                  ss[r] = s; }
#pragma unroll
              for (int o = 1; o < 64; o <<= 1) {
#pragma unroll
                  for (int r = 0; r < 4; ++r) ss[r] += __shfl_xor(ss[r], o); }
#pragma unroll
              for (int r = 0; r < 4; ++r) { const int m = m0 + r * NGW; if (m < T) { const float rs = __builtin_amdgcn_rsqf(ss[r] * (1.0f / D) + EPS); u32x2* o8 = (u32x2*)(XB + (size_t)m * D) + lane;
#pragma unroll
                  for (int j = 0; j < 4; ++j) { const f32x4 z = v[r][j] * rs * gg[j]; u32x2 w; w.x = cvt_pk_bf16(z[0], z[1]); w.y = cvt_pk_bf16(z[2], z[3]); o8[64 * j] = w; } } }
          } }
        if (bx < 8 && wid == 0) {
            const int h = bx; const float* rb = args.in[I_RELB] + h * 257;
            float bv[5];
#pragma unroll
            for (int i = 0; i < 5; ++i) { const int idx = lane + 64 * i; bv[i] = rb[idx < 257 ? idx : 256]; }
            const float qv = fabsf(args.in[I_QG][lane]), kv = fabsf(args.in[I_KG][lane]);
            float mb = fmaxf(fmaxf(fmaxf(bv[0], bv[1]), fmaxf(bv[2], bv[3])), bv[4]);
            mb = wave_max(mb); const float mq = wave_max(qv), mk = wave_max(kv);
            if (lane == 0) MHp[h] = 8.0f * mq * mk + mb;
        }
        if (bx >= 8 && bx < 136) {
            const int idx = (bx - 8) * 512 + tid, jj = idx & 127, s_ = jj >> 4, hi_ = (jj >> 3) & 1, e_ = jj & 7;
            const int j = 16 * s_ + (e_ < 4 ? 4 * hi_ + e_ : 8 + 4 * hi_ + (e_ - 4));
            WSB[idx] = (bf16_t)(cvt_pk_bf16(args.in[I_WS][(idx & ~127) + j], 0.f) & 0xffffu);
        }
        __syncthreads();
        if (BOTH(0)) GRID_BAR();
    }

#define P1_BODY() do { pg8::DenseSched S; S.o.init(T / 256, NPROJ / 256, G, bx); S.A = (const char*)XB; S.Bt = (const char*)WIN; \
        pg8::EpiInProj E{QB, args.in[I_QG], args.in[I_KG], SSQGV}; \
        pg8::gemm_phase<pg8::EpiInProj, pg8::DenseSched, true, true>(lds, S, E); } while (0)
    if (IN(1)) {
        P1_BODY();
#if PROBE_REP == 1
        GRID_BAR(); P1_BODY();
#endif
        if (BOTH(1)) GRID_BAR();
    }

#define P2A_BODY() do { const int qb = bx & 15, h = (bx >> 4) & 7, b0 = bx >> 7; \
        if (qb >= 2) att::attn_units<true>(b0, 2, 4, h, qb, QB, QB + QSTRIDE, QB + 2 * QSTRIDE, MIX, SSQAT, args.in[I_RELB], MHp, args.in[I_GATT], lds); \
        else att::attn_units<false>(b0, 2, 4, h, qb, QB, QB + QSTRIDE, QB + 2 * QSTRIDE, MIX, SSQAT, args.in[I_RELB], MHp, args.in[I_GATT], lds); } while (0)
#define P2G_BODY() do { for (int u = bx; u < 256; u += G) \
                gm::gmlp_unit(u >> 5, u & 31, QB + 3 * QSTRIDE, QB + 4 * QSTRIDE, SSQGV, WSB, args.in[I_BS], args.in[I_GVN], args.in[I_GGM], MIX, lds); } while (0)
    if (IN(2)) {
        P2A_BODY();
#if PROBE_REP == 2
        P2A_BODY();
#endif
        for (int rep = 0; rep < NREP(9); ++rep) P2G_BODY();
        if (BOTH(2)) GRID_BAR();
    }

#define P3_BODY() do { pg8::DenseSched S; S.o.init(T / 256, D / 256, G, bx); S.A = (const char*)MIX; S.Bt = (const char*)WO; \
        pg8::EpiOutProj E{MO, SSQAT, x}; \
        pg8::gemm_phase<pg8::EpiOutProj, pg8::DenseSched, true, true>(lds, S, E); } while (0)
#define P3X_BODY(first_) do { const int lane_ = opaque_tid() & 63; _Pragma("unroll 1") for (int s_ = 0; s_ < 4; ++s_) { \
        const XItem xd = xitem_decode((first_) + (bx >> 1) * 32 + wid * 4 + s_, args.in[I_WE1], (unsigned char*)W1, lane_); f32x4 xw[16]; xitem_load(xd, xw); xitem_store(xd, xw); } } while (0)
    if (IN(3)) {
        if (bx & 1) P3X_BODY(0);
        P3_BODY();
        if (!(bx & 1)) P3X_BODY(4096);
#if PROBE_REP == 3
        GRID_BAR(); P3_BODY();
#endif
        if (BOTH(3)) GRID_BAR();
    }

    if (IN(4)) {
#if PROBE_REP == 4
        p4_router(lds, x, MO, HB, GATES, (int*)ACT, ctl + CW_ECNT + 1024, args.in[I_GMOE], args.in[I_WR], args.in[I_BR], G, bx, args.in[I_WE1], (unsigned char*)W1);
        GRID_BAR();
#endif
        p4_router(lds, x, MO, HB, GATES, LIST, ECNT, args.in[I_GMOE], args.in[I_WR], args.in[I_BR], G, bx, args.in[I_WE1], (unsigned char*)W1);
        if (BOTH(4)) GRID_BAR();
    }

    LAS int* ptl = (LAS int*)(lds + LDS_PT); LAS int* cntl = (LAS int*)(lds + LDS_PT + 256);
    if (IN(5) || IN(6)) {
        if (tid < 64) { const int e = lane & 31; const int c = (int)__hip_atomic_load(ECNT + e, __ATOMIC_RELAXED, __HIP_MEMORY_SCOPE_AGENT); const int nt_e = (c + 255) >> 8;
            int incl = nt_e;
#pragma unroll
            for (int o = 1; o < 32; o <<= 1) { const int up = __shfl_up(incl, o, 32); if (e >= o) incl += up; }
            if (tid < 32) { cntl[e] = c; ptl[e + 1] = incl; if (e == 0) ptl[0] = 0; } }
        __syncthreads();
    }
    if (IN(5)) for (int rep = 0; rep < NREP(5); ++rep) {
        if (rep) GRID_BAR();
        pg8::GroupSched<true> S; S.o.init(ptl[32], 2048 / 256, G, bx); S.pt = ptl; S.cnt = cntl; S.A = (const char*)HB; S.Bt = (const char*)W1; S.nrows = 2048; S.list = LIST;
        pg8::EpiSwiglu E{ACT, args.in[I_BE1]};
        pg8::gemm_phase<pg8::EpiSwiglu, pg8::GroupSched<true>, true, true, true>(lds, S, E);
        {
            constexpr int I_2 = 8 * 32;
            for (;;) {
                __syncthreads();
                if (tid == 0) MISC[24] = __hip_atomic_fetch_add(ctl + CW_W2Q, 16u, __ATOMIC_RELAXED, __HIP_MEMORY_SCOPE_AGENT);
                __syncthreads();
                const int base = (int)MISC[24];
                if (base >= NE * I_2) break;
#pragma unroll 1
                for (int sub = 0; sub < 2; ++sub) { const int it = base + 2 * wid + sub;
                const int e = it / I_2, q = it % I_2, kb = q / 32, nb = q % 32;
                transpose_item<128, true>(args.in[I_WE2] + (size_t)e * DE * D, DE, D, (unsigned char*)W2 + (size_t)e * D * DE, 32 * nb, 128 * kb, 32 * nb, pg8::WSCALE, lane); }
            }
        }
        if (BOTH(5)) GRID_BAR();
    }
    if (IN(6)) for (int rep = 0; rep < NREP(6); ++rep) {
        if (rep) GRID_BAR();
        pg8::GroupSched<false, true> S; S.o.init(ptl[32], D / 256, G, bx); S.pt = ptl; S.cnt = cntl; S.A = (const char*)ACT; S.Bt = (const char*)W2; S.nrows = 1024; S.list = LIST;
        pg8::EpiDown E{Y, args.in[I_BE2], LIST, cntl};
        pg8::gemm_phase<pg8::EpiDown, pg8::GroupSched<false, true>, true, true, true, true>(lds, S, E);
        if (BOTH(6)) GRID_BAR();
    }
    if (IN(7)) for (int rep7 = 0; rep7 < NREP(7); ++rep7) {
        float* const dst7 = (NREP(7) == 2 && rep7 == 0) ? (float*)ACT : out;
        const int lane = opaque_tid() & 63;
#pragma unroll 2
        for (int m = gw; m < T; m += NGW) {
            const f32x4 gt = *(const f32x4*)(GATES + (size_t)m * 4);
            const u32x2* mr = (const u32x2*)(MO + (size_t)m * D) + lane; f32x4 v[4];
#pragma unroll
            for (int j = 0; j < 4; ++j) { const u32x2 mv = __builtin_nontemporal_load(mr + 64 * j);
                v[j] = (f32x4){__builtin_bit_cast(float, mv.x << 16), __builtin_bit_cast(float, mv.x & 0xffff0000u), __builtin_bit_cast(float, mv.y << 16), __builtin_bit_cast(float, mv.y & 0xffff0000u)}; }
#pragma unroll
            for (int k = 0; k < 4; ++k) { const unsigned* yr = (const unsigned*)(Y + ((size_t)m * 4 + k) * D) + lane; const float gk = gt[k];
#pragma unroll
                for (int j = 0; j < 4; ++j) { const unsigned w = __builtin_nontemporal_load(yr + 64 * j);
                    const f32x2 lo = __builtin_amdgcn_cvt_pk_f32_fp8((int)w, false), hi2 = __builtin_amdgcn_cvt_pk_f32_fp8((int)w, true);
                    v[j][0] += gk * lo[0]; v[j][1] += gk * lo[1]; v[j][2] += gk * hi2[0]; v[j][3] += gk * hi2[1]; } }
            f32x4* orow = (f32x4*)(dst7 + (size_t)m * D) + lane;
#pragma unroll
            for (int j = 0; j < 4; ++j) __builtin_nontemporal_store(v[j], orow + 64 * j);
        }
    }
#undef IN
#undef BOTH
}

extern "C" void kernel_launch(void* const* d_in, const int* in_sizes, int n_in, void* d_out, int out_size, void* d_ws, size_t ws_size, hipStream_t stream) {
    static int grid = 0;
    if (grid == 0) {
        if (n_in != 19 || in_sizes[0] != T * D || out_size != T * D || ws_size < WS_END) { fprintf(stderr, "kernel_launch: unexpected shapes (n_in %d, in0 %d, out %d, ws %zu)\n", n_in, n_in > 0 ? in_sizes[0] : -1, out_size, ws_size); grid = -1; return; }
        int dev = 0, cus = 0, per_cu = 0;
        if (hipGetDevice(&dev) != hipSuccess || hipDeviceGetAttribute(&cus, hipDeviceAttributeMultiprocessorCount, dev) != hipSuccess) { grid = -1; return; }
        if (hipFuncSetAttribute((const void*)fwd_kernel, hipFuncAttributeMaxDynamicSharedMemorySize, LDS_BYTES) != hipSuccess) { fprintf(stderr, "kernel_launch: hipFuncSetAttribute failed\n"); grid = -1; return; }
        if (hipOccupancyMaxActiveBlocksPerMultiprocessor(&per_cu, (const void*)fwd_kernel, 512, LDS_BYTES) != hipSuccess || per_cu < 1) fprintf(stderr, "kernel_launch: occupancy query reports %d\n", per_cu);
        (void)hipGetLastError();
        grid = cus;
        if (grid != 256) { fprintf(stderr, "kernel_launch: built for a 256-CU device (work maps assume 256 workgroups), found %d CUs; nothing launched\n", cus); grid = -1; return; }
    }
    if (grid < 0) return;
    (void)hipMemsetAsync((char*)d_ws + WS_CTL, 0, CTL_ZERO_BYTES, stream);
    Args a{};
    for (int i = 0; i < 19; ++i) a.in[i] = (const float*)d_in[i];
    a.out = (float*)d_out; a.ws = (unsigned char*)d_ws;
#if MK_SPLIT
    for (int p = 0; p < 8; ++p) { a.ph_lo = p; a.ph_hi = p + 1; hipLaunchKernelGGL(fwd_kernel, dim3(grid), dim3(512), LDS_BYTES, stream, a); }
#else
    a.ph_lo = 0; a.ph_hi = 8;
    hipLaunchKernelGGL(fwd_kernel, dim3(grid), dim3(512), LDS_BYTES, stream, a);
#endif
}
```

```cpp
#include <hip/hip_runtime.h>
#include <cstdio>
#include <cstdint>

#define GAS __attribute__((address_space(1)))
#define LAS __attribute__((address_space(3)))
typedef unsigned short bf16_t;
typedef short bf16x8 __attribute__((ext_vector_type(8)));
typedef short s16x4 __attribute__((ext_vector_type(4)));
typedef float f32x2 __attribute__((ext_vector_type(2)));
typedef float f32x4 __attribute__((ext_vector_type(4)));
typedef float f32x16 __attribute__((ext_vector_type(16)));
typedef unsigned u32x2 __attribute__((ext_vector_type(2)));
typedef unsigned u32x4 __attribute__((ext_vector_type(4)));
typedef int i32x4 __attribute__((ext_vector_type(4)));
typedef int i32x8 __attribute__((ext_vector_type(8)));

#ifndef PROBE_REP
#define PROBE_REP -1
#endif
#define NREP(k) ((k) == PROBE_REP ? 2 : 1)
#ifndef MK_SPLIT
#define MK_SPLIT 0
#endif

constexpr int NBATCH = 8, SEQ = 4096, D = 1024, T = NBATCH * SEQ;
constexpr int NPROJ = 2560, NE = 32, TOPK = 4, DE = 1024;
constexpr int NA = T * TOPK;
constexpr int LISTCAP = T;
constexpr float EPS = 1e-6f;
constexpr float LOG2E = 1.4426950408889634f;
constexpr float C2 = 0.125f * LOG2E;

constexpr size_t MiB = 1u << 20;
constexpr size_t WS_CTL = 0, CTL_ZERO_BYTES = 1 * MiB;
constexpr size_t WS_WIN = 1 * MiB;
constexpr size_t WS_WO = 6 * MiB;
constexpr size_t WS_W1 = 8 * MiB;
constexpr size_t WS_W2 = 136 * MiB;
constexpr size_t WS_HB = 200 * MiB;
constexpr size_t WS_SSQGV = 264 * MiB;
constexpr size_t WS_SSQAT = 265 * MiB;
constexpr size_t WS_GATES = 266 * MiB;
constexpr size_t WS_MH = 266 * MiB + 768 * 1024;
constexpr size_t WS_WSB = 266 * MiB + 832 * 1024;
constexpr size_t WS_LIST = 267 * MiB;
constexpr size_t WS_ACT = 272 * MiB;
constexpr size_t WS_Y = 672 * MiB;
constexpr size_t WS_XB = 544 * MiB;
constexpr size_t WS_MO = 608 * MiB;
constexpr size_t WS_Q = 608 * MiB;
constexpr size_t WS_MIX = 768 * MiB;
constexpr size_t WS_END = 800 * MiB;
constexpr size_t QSTRIDE = (size_t)T * 512;
constexpr int CW_BAR = 4096;
constexpr int CW_ECNT = 16384;
constexpr int CW_W2Q = 17408;

constexpr int RING_BYTES = 131072;
constexpr int LDS_BYTES = 163840;
constexpr int LDS_LCNT = LDS_BYTES - 3072;
constexpr int LDS_PT = LDS_BYTES - 2048;
constexpr int LDS_MISC = LDS_BYTES - 1024;

__device__ __forceinline__ unsigned cvt_pk_bf16(float lo, float hi) { unsigned r; asm volatile("v_cvt_pk_bf16_f32 %0, %1, %2" : "=v"(r) : "v"(lo), "v"(hi)); return r; }
__device__ __forceinline__ float bf2f(unsigned short b) { return __builtin_bit_cast(float, (unsigned)b << 16); }
__device__ __forceinline__ float wave_sum(float v) {
#pragma unroll
    for (int o = 1; o < 64; o <<= 1) v += __shfl_xor(v, o);
    return v;
}
__device__ __forceinline__ float wave_max(float v) {
#pragma unroll
    for (int o = 1; o < 64; o <<= 1) v = fmaxf(v, __shfl_xor(v, o));
    return v;
}
__device__ __forceinline__ int opaque_tid() { int t = threadIdx.x; asm volatile("" : "+v"(t)); return t; }
__device__ __forceinline__ void glds16(const void* gsrc, unsigned lds_dst) { unsigned keep;
    asm volatile("s_mov_b32 %0, m0\n\ts_mov_b32 m0, %2\n\ts_nop 0\n\tglobal_load_lds_dwordx4 %1, off\n\ts_mov_b32 m0, %0" : "=&s"(keep) : "v"(gsrc), "s"(lds_dst) : "memory"); }
__device__ __forceinline__ unsigned lds_addr(const LAS void* p) { return (unsigned)(size_t)p; }
#define LDS_WAIT() asm volatile("s_waitcnt lgkmcnt(0)" ::: "memory")
#define VM_WAIT() asm volatile("s_waitcnt vmcnt(0)" ::: "memory")

__device__ __forceinline__ f32x2 gelu_pk(f32x2 v) {
    const f32x2 av = __builtin_elementwise_abs(v), d = av * 0.2316418882f + 1.0f;
    f32x2 t; t.x = __builtin_amdgcn_rcpf(d.x); t.y = __builtin_amdgcn_rcpf(d.y);
    f32x2 q = t * 0.5307027145f + (-0.7265760135f); q = q * t + 0.7107068705f; q = q * t + (-0.142248368f); q = q * t + 0.127414796f; q = q * t;
    const f32x2 s = (v * v) * (-0.72134752044f);
    f32x2 e; e.x = __builtin_amdgcn_exp2f(s.x); e.y = __builtin_amdgcn_exp2f(s.y);
    const f32x2 m = v * (q * e), r = v - m;
    f32x2 o; o.x = v.x < 0.f ? m.x : r.x; o.y = v.y < 0.f ? m.y : r.y; return o;
}
__device__ __forceinline__ f32x4 gelu4(f32x4 v) { f32x2 a = gelu_pk((f32x2){v[0], v[1]}), b = gelu_pk((f32x2){v[2], v[3]}); return (f32x4){a.x, a.y, b.x, b.y}; }

namespace pg8 {
constexpr int BM = 256, BK = 64, HALF = 128, HTB = HALF * BK * 2, NXCD = 8, WGM = 4, KD = 1024;
__host__ __device__ __forceinline__ int lds_byte(int r, int c) { const int st = (r >> 4) * 2 + (c >> 5), rr = r & 15, cc = c & 31, ob = rr * 64 + cc * 2; return st * 1024 + (ob ^ (((ob >> 9) & 1) << 5)); }
__host__ __device__ __forceinline__ void stage_rc(int b, int& R, int& C) { const int st = b / 1024, sb = b % 1024, swz = sb ^ (((sb >> 9) & 1) << 5); R = (st >> 1) * 16 + swz / 64; C = (st & 1) * 32 + (swz % 64) / 2; }
__host__ __device__ __forceinline__ int perm32(int rho) { const int n = rho >> 4, i = rho & 15; return 8 * (i >> 2) + 4 * n + (i & 3); }

struct Unit { int pm, pn, e, mt; };

struct TileOrder {
    int nM, nN, nwg, G, c;
    __device__ __forceinline__ void init(int nM_, int nN_, int G_, int c_) { nM = nM_; nN = nN_; nwg = nM * nN; G = G_; c = c_; }
    __device__ __forceinline__ bool tile(int i, int& pm, int& pn) const {
        const long L = (long)i * G + c; if (L >= nwg) return false;
        int wgid = (int)L; { const int q = nwg / NXCD, r = nwg % NXCD, xcd = wgid % NXCD, off = wgid / NXCD; wgid = (xcd < r ? xcd * (q + 1) : r * (q + 1) + (xcd - r) * q) + off; }
        const int nig = WGM * nN, gid = wgid / nig, fm = gid * WGM, gsz = (nM - fm) < WGM ? (nM - fm) : WGM;
        pm = fm + ((wgid % nig) % gsz); pn = (wgid % nig) / gsz; return true;
    }
};

__device__ __forceinline__ i32x8 cat8(bf16x8 a, bf16x8 b) { const i32x4 x = __builtin_bit_cast(i32x4, a), y = __builtin_bit_cast(i32x4, b); return __builtin_shufflevector(x, y, 0, 1, 2, 3, 4, 5, 6, 7); }
template <class Epi, class Sched, bool ALIGN_EPI, bool SP2, bool FP8 = false, bool COL16 = false>
__device__ __forceinline__ void gemm_phase(LAS unsigned char* lds, const Sched& S, const Epi& E) {
    const int tid = opaque_tid(), wid = __builtin_amdgcn_readfirstlane(tid >> 6), lane = tid & 63, wr = wid >> 2, wc = wid & 3, fr = lane & 15, fq = lane >> 4;
    constexpr int K = FP8 ? KD / 2 : KD  , nt = K / BK;
    int sR[2], sC[2];
    unsigned voffB[2], vA[2][2];
#pragma unroll
    for (int i = 0; i < 2; ++i) {
        sR[i] = 8 * (wid + 8 * i) + (lane >> 3); sC[i] = 8 * ((lane & 7) ^ ((sR[i] >> 1) & 7)); const int rho = sR[i] & 31;
        const int Rb = COL16 ? 64 * (sR[i] >> 5) + 16 * ((rho & 15) >> 2) + 4 * (rho >> 4) + (rho & 3) : 64 * (sR[i] >> 5) + perm32(rho);
        voffB[i] = (unsigned)(Rb * K + sC[i]) * 2u;
        vA[0][i] = (unsigned)(sR[i] * K + sC[i]) * 2u; vA[1][i] = (unsigned)((sR[i] + HALF) * K + sC[i]) * 2u; }
    constexpr size_t kstep = (size_t)(BK * 2);
    constexpr size_t hstepB = (size_t)(COL16 ? 8 : 32) * K * 2;
    const unsigned ldsw = (unsigned)wid * 1024u;
    const int aoff0 = (wr * 64 + fr) * 128 + 16 * (fq ^ (fr >> 1)), aoff1 = (wr * 64 + fr) * 128 + 16 * ((4 + fq) ^ (fr >> 1));
    const int boff0 = (wc * 32 + fr) * 128 + 16 * (fq ^ (fr >> 1)), boff1 = (wc * 32 + fr) * 128 + 16 * ((4 + fq) ^ (fr >> 1));
#define PG8_SA(b, h) (((b) * 2 + (h)) * HTB)
#define PG8_SB(b, h) ((4 + (b) * 2 + (h)) * HTB)
#define PG8_STAGE(bufoff, gbase, v0, v1) do { \
        __builtin_amdgcn_global_load_lds((const unsigned*)((const char*)(gbase) + (v0)), (LAS unsigned*)(lds + (bufoff) + ldsw), 16, 0, 0); \
        __builtin_amdgcn_global_load_lds((const unsigned*)((const char*)(gbase) + (v1)), (LAS unsigned*)(lds + (bufoff) + ldsw + 8192), 16, 0, 0); } while (0)
#define PG8_STAGE_B(bufoff, gbase) PG8_STAGE(bufoff, gbase, voffB[0], voffB[1])
#define PG8_STAGE_A(bufoff, gbase, V, h) PG8_STAGE(bufoff, gbase, V[h][0], V[h][1])
#define PG8_LDA(dst, b, h) do { _Pragma("unroll") for (int m = 0; m < 4; ++m) { \
        if constexpr (FP8) { const i32x4 lo_ = *(const LAS i32x4*)(lds + PG8_SA(b, h) + aoff0 + m * 2048), hi_ = *(const LAS i32x4*)(lds + PG8_SA(b, h) + aoff1 + m * 2048); dst##8[m] = __builtin_shufflevector(lo_, hi_, 0, 1, 2, 3, 4, 5, 6, 7); } \
        else { dst[m][0] = *(const LAS bf16x8*)(lds + PG8_SA(b, h) + aoff0 + m * 2048); dst[m][1] = *(const LAS bf16x8*)(lds + PG8_SA(b, h) + aoff1 + m * 2048); } } } while (0)
#define PG8_LDB(dst, b, h) do { _Pragma("unroll") for (int n = 0; n < 2; ++n) { \
        if constexpr (FP8) { const i32x4 lo_ = *(const LAS i32x4*)(lds + PG8_SB(b, h) + boff0 + n * 2048), hi_ = *(const LAS i32x4*)(lds + PG8_SB(b, h) + boff1 + n * 2048); dst##8[n] = __builtin_shufflevector(lo_, hi_, 0, 1, 2, 3, 4, 5, 6, 7); } \
        else { dst[n][0] = *(const LAS bf16x8*)(lds + PG8_SB(b, h) + boff0 + n * 2048); dst[n][1] = *(const LAS bf16x8*)(lds + PG8_SB(b, h) + boff1 + n * 2048); } } } while (0)
#define PG8_MMA(ai, bj, At, Bt) do { __builtin_amdgcn_s_setprio(1); _Pragma("unroll") for (int m = 0; m < 4; ++m) _Pragma("unroll") for (int n = 0; n < 2; ++n) { \
        if constexpr (FP8) asm volatile("v_mfma_scale_f32_16x16x128_f8f6f4 %0, %1, %2, %0, %3, %3 op_sel_hi:[0,0,0]" : "+v"(acc[ai][bj][m][n]) : "v"(Bt##8[n]), "v"(At##8[m]), "v"(scl)); \
        else { _Pragma("unroll") for (int k = 0; k < 2; ++k) acc[ai][bj][m][n] = __builtin_amdgcn_mfma_f32_16x16x32_bf16(Bt[n][k], At[m][k], acc[ai][bj][m][n], 0, 0, 0); } } \
        __builtin_amdgcn_s_setprio(0); } while (0)
#define PG8_WAIT_V(n) asm volatile("s_waitcnt vmcnt(" #n ")" ::: "memory")
#define PG8_WAIT_L(n) asm volatile("s_waitcnt lgkmcnt(" #n ")" ::: "memory")
#define PG8_BAR __builtin_amdgcn_s_barrier()
#define PG8_SCHED __builtin_amdgcn_sched_barrier(0)
    Unit cur, nxt; int ui = 0;
    if (!S.next(0, cur)) return;
    LAS u32x4* const gslot = (LAS u32x4*)(lds + 131072) + tid;
    LAS unsigned char* const metab = lds + 139264;
    if constexpr (Sched::GATHER) { S.gather(cur, sR, sC, vA); Unit u1; if (S.next(1, u1)) { unsigned t_[2][2]; S.gather(u1, sR, sC, t_); *gslot = (u32x4){t_[0][0], t_[0][1], t_[1][0], t_[1][1]}; } }
    if constexpr (Epi::META) E.meta_finish(E.meta_issue(cur, tid), metab, tid);
    f32x4 acc[2][2][4][2];
#pragma unroll
    for (int a = 0; a < 2; ++a)
#pragma unroll
        for (int b = 0; b < 2; ++b)
#pragma unroll
            for (int m = 0; m < 4; ++m)
#pragma unroll
                for (int n = 0; n < 2; ++n) acc[a][b][m][n] = (f32x4){0.f, 0.f, 0.f, 0.f};
    bf16x8 At[4][2], B0[2][2], B1[2][2]; i32x8 At8[4], B08[2], B18[2];
    unsigned scl = 0x7F7F7F7Fu; asm volatile("" : "+v"(scl));
    const char* cA = S.a_ptr(cur); const char* cB = S.b_ptr(cur);
    if constexpr (SP2) {
        PG8_STAGE_B(PG8_SB(0, 0), cB); PG8_STAGE_B(PG8_SB(0, 1), cB + hstepB); PG8_STAGE_A(PG8_SA(0, 0), cA, vA, 0); PG8_STAGE_A(PG8_SA(0, 1), cA, vA, 1);
        if (wr == 1) PG8_BAR;
        PG8_WAIT_V(2); PG8_BAR;
        PG8_STAGE_B(PG8_SB(1, 0), cB + kstep); PG8_STAGE_A(PG8_SA(1, 0), cA + kstep, vA, 0); PG8_STAGE_B(PG8_SB(1, 1), cB + hstepB + kstep);
        PG8_WAIT_V(6); PG8_BAR;
    } else {
        PG8_STAGE_B(PG8_SB(0, 0), cB); PG8_STAGE_A(PG8_SA(0, 0), cA, vA, 0); PG8_STAGE_B(PG8_SB(0, 1), cB + hstepB); PG8_STAGE_A(PG8_SA(0, 1), cA, vA, 1);
        if (wr == 1) PG8_BAR;
        PG8_WAIT_V(4); PG8_BAR;
        PG8_STAGE_B(PG8_SB(1, 0), cB + kstep); PG8_STAGE_A(PG8_SA(1, 0), cA + kstep, vA, 0); PG8_STAGE_B(PG8_SB(1, 1), cB + hstepB + kstep);
        PG8_WAIT_V(6); PG8_BAR;
    }
    for (;;) {
        const bool has_next = S.next(ui + 1, nxt);
        const char* nA = has_next ? S.a_ptr(nxt) : cA; const char* nB = has_next ? S.b_ptr(nxt) : cB;
        unsigned w2[2][2] = {{vA[0][0], vA[0][1]}, {vA[1][0], vA[1][1]}};
        for (int t = 0; t < nt; t += 2) {
            const bool last = (t == nt - 2);
            if constexpr (Epi::HAS_MID) { if (t == nt / 2) E.mid(acc, cur, wr, wc, fr, fq); }
            const char* a1 = cA + (size_t)(t + 1) * kstep;
            const char* a2 = last ? nA : cA + (size_t)(t + 2) * kstep; const char* b2 = last ? nB : cB + (size_t)(t + 2) * kstep;
            const char* a3 = a2 + kstep; const char* b3 = b2 + kstep;
            if constexpr (Sched::GATHER) { if (last && has_next) { const u32x4 r_ = *gslot; w2[0][0] = r_[0]; w2[0][1] = r_[1]; w2[1][0] = r_[2]; w2[1][1] = r_[3]; } }
            if constexpr (SP2) {
            PG8_LDB(B0, 0, 0); PG8_LDB(B1, 0, 1); PG8_SCHED; PG8_LDA(At, 0, 0); PG8_STAGE_A(PG8_SA(1, 1), a1, vA, 1);
            PG8_WAIT_V(8); PG8_WAIT_L(0); PG8_BAR; PG8_MMA(0, 0, At, B0); PG8_MMA(0, 1, At, B1); PG8_BAR; PG8_SCHED;
            PG8_LDA(At, 0, 1); PG8_STAGE_B(PG8_SB(0, 0), b2); PG8_STAGE_B(PG8_SB(0, 1), b2 + hstepB); PG8_STAGE_A(PG8_SA(0, 0), a2, w2, 0);
            PG8_WAIT_V(8); PG8_WAIT_L(0); PG8_BAR; PG8_MMA(1, 0, At, B0); PG8_MMA(1, 1, At, B1); PG8_BAR; PG8_SCHED;
            PG8_LDB(B0, 1, 0); PG8_LDB(B1, 1, 1); PG8_SCHED; PG8_LDA(At, 1, 0); PG8_STAGE_A(PG8_SA(0, 1), a2, w2, 1);
            PG8_WAIT_V(8); PG8_WAIT_L(0); PG8_BAR; PG8_MMA(0, 0, At, B0); PG8_MMA(0, 1, At, B1); PG8_BAR; PG8_SCHED;
            PG8_LDA(At, 1, 1); PG8_STAGE_B(PG8_SB(1, 0), b3); PG8_STAGE_B(PG8_SB(1, 1), b3 + hstepB); PG8_STAGE_A(PG8_SA(1, 0), a3, w2, 0);
            PG8_WAIT_V(8); PG8_WAIT_L(0); PG8_BAR; PG8_MMA(1, 0, At, B0); PG8_MMA(1, 1, At, B1); PG8_BAR; PG8_SCHED;
            } else {
            PG8_LDB(B0, 0, 0); PG8_SCHED; PG8_LDA(At, 0, 0); PG8_STAGE_A(PG8_SA(1, 1), a1, vA, 1);
            PG8_WAIT_L(8); PG8_BAR; PG8_WAIT_L(0); PG8_MMA(0, 0, At, B0); PG8_BAR; PG8_SCHED;
            PG8_LDB(B1, 0, 1); PG8_STAGE_B(PG8_SB(0, 0), b2);
            PG8_BAR; PG8_WAIT_L(0); PG8_MMA(0, 1, At, B1); PG8_BAR;
            PG8_LDA(At, 0, 1); PG8_STAGE_A(PG8_SA(0, 0), a2, w2, 0);
            PG8_BAR; PG8_WAIT_L(0); PG8_MMA(1, 0, At, B0); PG8_BAR; PG8_SCHED;
            PG8_STAGE_B(PG8_SB(0, 1), b2 + hstepB);
            PG8_WAIT_V(6); PG8_BAR; PG8_MMA(1, 1, At, B1); PG8_BAR;
            PG8_LDB(B0, 1, 0); PG8_SCHED; PG8_LDA(At, 1, 0); PG8_STAGE_A(PG8_SA(0, 1), a2, w2, 1);
            PG8_WAIT_L(8); PG8_BAR; PG8_WAIT_L(0); PG8_MMA(0, 0, At, B0); PG8_BAR; PG8_SCHED;
            PG8_LDB(B1, 1, 1); PG8_STAGE_B(PG8_SB(1, 0), b3);
            PG8_BAR; PG8_WAIT_L(0); PG8_MMA(0, 1, At, B1); PG8_BAR;
            PG8_LDA(At, 1, 1); PG8_STAGE_A(PG8_SA(1, 0), a3, w2, 0);
            PG8_BAR; PG8_WAIT_L(0); PG8_MMA(1, 0, At, B0); PG8_BAR; PG8_SCHED;
            PG8_STAGE_B(PG8_SB(1, 1), b3 + hstepB);
            PG8_WAIT_V(6); PG8_BAR; PG8_MMA(1, 1, At, B1); PG8_BAR;
            }
        }
        if constexpr (ALIGN_EPI) { if (wr == 0) PG8_BAR; }
        if constexpr (FP8) asm volatile("s_nop 15\n\ts_nop 15" ::: "memory");
        {
            Unit n2; bool h2 = false; int raw_[2][2] = {{0, 0}, {0, 0}}; unsigned mreg_ = 0u;
            if constexpr (Sched::GATHER) { h2 = S.next(ui + 2, n2); if (h2) S.gather_issue(n2, sR, raw_); }
            if constexpr (Epi::META) { if (has_next) mreg_ = E.meta_issue(nxt, tid); }
            if constexpr (Epi::META) E.run(acc, cur, wr, wc, fr, fq, metab + (ui & 1) * 2048); else E(acc, cur, wr, wc, fr, fq);
            if constexpr (Sched::GATHER) { if (h2) { unsigned t_[2][2]; S.gather_finish(raw_, sC, t_); *gslot = (u32x4){t_[0][0], t_[0][1], t_[1][0], t_[1][1]}; } }
            if constexpr (Epi::META) { if (has_next) E.meta_finish(mreg_, metab + ((ui + 1) & 1) * 2048, tid); }
        }
        if (!has_next) break;
#pragma unroll
        for (int a = 0; a < 2; ++a)
#pragma unroll
            for (int b = 0; b < 2; ++b)
#pragma unroll
                for (int m = 0; m < 4; ++m)
#pragma unroll
                    for (int n = 0; n < 2; ++n) acc[a][b][m][n] = (f32x4){0.f, 0.f, 0.f, 0.f};
        if constexpr (FP8) asm volatile("s_nop 7" ::: "memory");
        cur = nxt; cA = nA; cB = nB; ++ui;
        if constexpr (Sched::GATHER) {
#pragma unroll
            for (int h = 0; h < 2; ++h)
#pragma unroll
                for (int i = 0; i < 2; ++i) vA[h][i] = w2[h][i];
        }
        if constexpr (ALIGN_EPI) { if (wr == 1) PG8_BAR; }
    }
    PG8_WAIT_V(0);
    if constexpr (!ALIGN_EPI) { if (wr == 0) PG8_BAR; }
    PG8_BAR;
#undef PG8_SA
#undef PG8_SB
#undef PG8_STAGE
#undef PG8_STAGE_A
#undef PG8_STAGE_B
#undef PG8_LDA
#undef PG8_LDB
#undef PG8_MMA
#undef PG8_WAIT_V
#undef PG8_WAIT_L
#undef PG8_BAR
#undef PG8_SCHED
}

struct DenseSched {
    static constexpr bool GATHER = false; static constexpr int KB = KD * 2;
    TileOrder o; const char* A; const char* Bt;
    __device__ __forceinline__ bool next(int i, Unit& u) const { if (!o.tile(i, u.pm, u.pn)) return false; u.e = 0; u.mt = u.pm; return true; }
    __device__ __forceinline__ const char* a_ptr(const Unit& u) const { return A + (size_t)u.pm * ((size_t)BM * KB); }
    __device__ __forceinline__ const char* b_ptr(const Unit& u) const { return Bt + (size_t)u.pn * ((size_t)BM * KB); }
    __device__ __forceinline__ void gather(const Unit&, const int (&)[2], const int (&)[2], unsigned (&)[2][2]) const {}
    __device__ __forceinline__ void gather_issue(const Unit&, const int (&)[2], int (&)[2][2]) const {}
    __device__ __forceinline__ void gather_finish(const int (&)[2][2], const int (&)[2], unsigned (&)[2][2]) const {}
};
template <bool GATHER_>
struct GroupSched {
    static constexpr bool GATHER = GATHER_; static constexpr int KB = KD;
    TileOrder o; const LAS int* pt; const LAS int* cnt; const char* A; const char* Bt; int nrows; const int* list;
    __device__ __forceinline__ bool next(int i, Unit& u) const {
        if (!o.tile(i, u.pm, u.pn)) return false;
        const int lane = threadIdx.x & 63;
        const int pe = pt[(lane & 31) + 1];
        const unsigned long long bal = __ballot(u.pm >= pe) & 0xffffffffull;
        const int e = __builtin_amdgcn_readfirstlane(__popcll(bal)); u.e = e > 31 ? 31 : e; u.mt = u.pm - __builtin_amdgcn_readfirstlane(pt[u.e]); return true;
    }
    __device__ __forceinline__ const char* a_ptr(const Unit& u) const { return GATHER ? A : A + (size_t)u.pm * ((size_t)BM * KB); }
    __device__ __forceinline__ const char* b_ptr(const Unit& u) const { return Bt + ((size_t)u.e * nrows + (size_t)u.pn * BM) * ((size_t)KB); }
    __device__ __forceinline__ void gather_issue(const Unit& u, const int (&sR)[2], int (&raw)[2][2]) const {
        const int n = cnt[u.e];
#pragma unroll
        for (int h = 0; h < 2; ++h)
#pragma unroll
            for (int i = 0; i < 2; ++i) { const int idx = u.mt * BM + h * HALF + sR[i]; raw[h][i] = list[u.e * LISTCAP + (idx < n ? idx : n - 1)]; }
    }
    __device__ __forceinline__ void gather_finish(const int (&raw)[2][2], const int (&sC)[2], unsigned (&v)[2][2]) const {
#pragma unroll
        for (int h = 0; h < 2; ++h)
#pragma unroll
            for (int i = 0; i < 2; ++i) v[h][i] = (unsigned)((raw[h][i] >> 2) * KB + sC[i] * 2);
    }
    __device__ __forceinline__ void gather(const Unit& u, const int (&sR)[2], const int (&sC)[2], unsigned (&v)[2][2]) const { int raw[2][2]; gather_issue(u, sR, raw); gather_finish(raw, sC, v); }
};

__device__ __forceinline__ u32x4 pack8(f32x4 a, f32x4 b) { u32x4 w; w.x = cvt_pk_bf16(a[0], a[1]); w.y = cvt_pk_bf16(a[2], a[3]); w.z = cvt_pk_bf16(b[0], b[1]); w.w = cvt_pk_bf16(b[2], b[3]); return w; }

__device__ __forceinline__ float clamp448(float v) { return fminf(fmaxf(v, -448.0f), 448.0f); }
__device__ __forceinline__ unsigned pack4_fp8(f32x4 a) { int p = 0; p = __builtin_amdgcn_cvt_pk_fp8_f32(clamp448(a[0]), clamp448(a[1]), p, false); p = __builtin_amdgcn_cvt_pk_fp8_f32(clamp448(a[2]), clamp448(a[3]), p, true); return (unsigned)p; }
__device__ __forceinline__ unsigned pack4_fp8_nc(f32x4 a) { int p = 0; p = __builtin_amdgcn_cvt_pk_fp8_f32(a[0], a[1], p, false); p = __builtin_amdgcn_cvt_pk_fp8_f32(a[2], a[3], p, true); return (unsigned)p; }
constexpr float WSCALE = 32.0f, WINV = 1.0f / 32.0f;

struct EpiInProj {
    static constexpr bool HAS_MID = false, META = false;
    bf16_t* obase; const float* qg; const float* kg; float* ssq_gv;
    __device__ __forceinline__ void mid(f32x4 (&)[2][2][4][2], const Unit&, int, int, int, int) const {}
    __device__ __forceinline__ void operator()(const f32x4 (&acc)[2][2][4][2], const Unit& u, int wr, int wc, int fr, int fq) const {
        const int kind = u.pn >> 1;
        bf16_t* O = obase + (size_t)kind * QSTRIDE;
        const int col0 = (u.pn & 1) * 256 + wc * 64 + 8 * fq;
        const int row0 = u.pm * BM + wr * 64 + fr;
        if (kind <= 1) {
            const float* g = kind == 0 ? qg : kg; const float sc = kind == 0 ? C2 : 1.0f;
            f32x4 gv[2][2];
#pragma unroll
            for (int bj = 0; bj < 2; ++bj)
#pragma unroll
                for (int n = 0; n < 2; ++n) gv[bj][n] = *(const f32x4*)(g + 32 * bj + 8 * fq + 4 * n) * sc;
#pragma unroll
            for (int ai = 0; ai < 2; ++ai)
#pragma unroll
                for (int m = 0; m < 4; ++m) {
                    float ss = 0.f;
#pragma unroll
                    for (int bj = 0; bj < 2; ++bj)
#pragma unroll
                        for (int n = 0; n < 2; ++n) { const f32x4 x = acc[ai][bj][m][n]; ss += (x[0] * x[0] + x[1] * x[1]) + (x[2] * x[2] + x[3] * x[3]); }
                    ss += __shfl_xor(ss, 16); ss += __shfl_xor(ss, 32);
                    const float rs = __builtin_amdgcn_rsqf(ss * (1.0f / 64.0f) + EPS);
                    bf16_t* rowp = O + (size_t)(row0 + ai * HALF + m * 16) * 512 + col0;
#pragma unroll
                    for (int bj = 0; bj < 2; ++bj) *(u32x4*)(rowp + 32 * bj) = pack8(acc[ai][bj][m][0] * rs * gv[bj][0], acc[ai][bj][m][1] * rs * gv[bj][1]);
                }
        } else if (kind == 2) {
#pragma unroll
            for (int ai = 0; ai < 2; ++ai)
#pragma unroll
                for (int m = 0; m < 4; ++m) { bf16_t* rowp = O + (size_t)(row0 + ai * HALF + m * 16) * 512 + col0;
#pragma unroll
                    for (int bj = 0; bj < 2; ++bj) *(u32x4*)(rowp + 32 * bj) = pack8(acc[ai][bj][m][0], acc[ai][bj][m][1]); }
        } else if (kind == 3) {
#pragma unroll
            for (int ai = 0; ai < 2; ++ai)
#pragma unroll
                for (int m = 0; m < 4; ++m) { bf16_t* rowp = O + (size_t)(row0 + ai * HALF + m * 16) * 512 + col0;
#pragma unroll
                    for (int bj = 0; bj < 2; ++bj) *(u32x4*)(rowp + 32 * bj) = pack8(gelu4(acc[ai][bj][m][0]), gelu4(acc[ai][bj][m][1])); }
        } else {
#pragma unroll
            for (int ai = 0; ai < 2; ++ai)
#pragma unroll
                for (int m = 0; m < 4; ++m) { const int row = row0 + ai * HALF + m * 16; bf16_t* rowp = O + (size_t)row * 512 + col0; float ss = 0.f;
#pragma unroll
                    for (int bj = 0; bj < 2; ++bj) { const f32x4 a = gelu4(acc[ai][bj][m][0]), b = gelu4(acc[ai][bj][m][1]);
                        ss += (a[0] * a[0] + a[1] * a[1]) + (a[2] * a[2] + a[3] * a[3]) + (b[0] * b[0] + b[1] * b[1]) + (b[2] * b[2] + b[3] * b[3]);
                        *(u32x4*)(rowp + 32 * bj) = pack8(a, b); }
                    ss += __shfl_xor(ss, 16); ss += __shfl_xor(ss, 32);
                    if (fq == 0) ssq_gv[(size_t)row * 8 + (u.pn & 1) * 4 + wc] = ss; }
        }
    }
};

struct EpiOutProj {
    static constexpr bool HAS_MID = true, META = false;
    bf16_t* mo; const float* ssq_att; const float* x;
    __device__ __forceinline__ void mid(f32x4 (&acc)[2][2][4][2], const Unit& u, int wr, int wc, int fr, int fq) const {
#pragma unroll
        for (int ai = 0; ai < 2; ++ai)
#pragma unroll
            for (int m = 0; m < 4; ++m) { const int row = u.pm * BM + ai * HALF + wr * 64 + m * 16 + fr;
                const f32x4 a = *(const f32x4*)(ssq_att + (size_t)row * 8), b = *(const f32x4*)(ssq_att + (size_t)row * 8 + 4);
                const float s = ((a[0] + a[1]) + (a[2] + a[3])) + ((b[0] + b[1]) + (b[2] + b[3]));
                const float rs = __builtin_amdgcn_rsqf(s * (1.0f / 512.0f) + EPS);
#pragma unroll
                for (int bj = 0; bj < 2; ++bj)
#pragma unroll
                    for (int n = 0; n < 2; ++n) acc[ai][bj][m][n] *= rs; }
    }
    __device__ __forceinline__ void operator()(const f32x4 (&acc)[2][2][4][2], const Unit& u, int wr, int wc, int fr, int fq) const {
        f32x4 xr[4][2][2];
#define OP_XLOAD(c) do { const float* xp_ = x + (size_t)(u.pm * BM + ((c) >> 2) * HALF + wr * 64 + ((c) & 3) * 16 + fr) * D + u.pn * BM + wc * 64 + 8 * fq; \
            _Pragma("unroll") for (int bj = 0; bj < 2; ++bj) { xr[(c) & 3][bj][0] = __builtin_nontemporal_load((const f32x4*)(xp_ + 32 * bj)); xr[(c) & 3][bj][1] = __builtin_nontemporal_load((const f32x4*)(xp_ + 32 * bj + 4)); } } while (0)
        OP_XLOAD(0); OP_XLOAD(1); OP_XLOAD(2); OP_XLOAD(3);
#pragma unroll
        for (int c = 0; c < 8; ++c) { const int ai = c >> 2, m = c & 3;
            bf16_t* rowp = mo + (size_t)(u.pm * BM + ai * HALF + wr * 64 + m * 16 + fr) * D + u.pn * BM + wc * 64 + 8 * fq;
#pragma unroll
            for (int bj = 0; bj < 2; ++bj) *(u32x4*)(rowp + 32 * bj) = pack8(acc[ai][bj][m][0] + xr[c & 3][bj][0], acc[ai][bj][m][1] + xr[c & 3][bj][1]);
            if (c + 4 < 8) { asm volatile("" ::: "memory"); OP_XLOAD(c + 4); }
        }
#undef OP_XLOAD
    }
};

struct EpiSwiglu {
    static constexpr bool HAS_MID = false, META = true;
    bf16_t* act; const float* b_in;
    __device__ __forceinline__ void mid(f32x4 (&)[2][2][4][2], const Unit&, int, int, int, int) const {}
    __device__ __forceinline__ unsigned meta_issue(const Unit& u, int tid) const {
        const int t = tid & 255; return __builtin_bit_cast(unsigned, b_in[(size_t)u.e * 2048 + (t >> 7) * 1024 + u.pn * 128 + (t & 127)] + (float)(t >> 7));
    }
    __device__ __forceinline__ void meta_finish(unsigned bits, LAS unsigned char* buf, int tid) const { if (tid < 256) ((LAS unsigned*)buf)[tid] = bits; }
    __device__ __forceinline__ void run(const f32x4 (&acc)[2][2][4][2], const Unit& u, int wr, int wc, int fr, int fq, const LAS unsigned char* buf) const {
        const int cl = wc * 32 + 8 * fq, col = u.pn * 128 + cl;
        f32x4 bg[2], bl[2];
#pragma unroll
        for (int n = 0; n < 2; ++n) { bg[n] = *(const LAS f32x4*)(buf + (cl + 4 * n) * 4); bl[n] = *(const LAS f32x4*)(buf + (128 + cl + 4 * n) * 4); }
#pragma unroll
        for (int ai = 0; ai < 2; ++ai)
#pragma unroll
            for (int m = 0; m < 4; ++m) { const size_t row = (size_t)u.pm * BM + ai * HALF + wr * 64 + m * 16 + fr; f32x4 o[2];
#pragma unroll
                for (int n = 0; n < 2; ++n)
#pragma unroll
                    for (int hh = 0; hh < 2; ++hh) {
                        const f32x2 ag = {acc[ai][0][m][n][2 * hh], acc[ai][0][m][n][2 * hh + 1]}, al = {acc[ai][1][m][n][2 * hh], acc[ai][1][m][n][2 * hh + 1]};
                        f32x2 g = ag * WINV + (f32x2){bg[n][2 * hh], bg[n][2 * hh + 1]}; g.x = fminf(g.x, 7.0f); g.y = fminf(g.y, 7.0f);
                        f32x2 l = al * WINV + (f32x2){bl[n][2 * hh], bl[n][2 * hh + 1]};
                        l.x = __builtin_amdgcn_fmed3f(l.x, -6.0f, 8.0f); l.y = __builtin_amdgcn_fmed3f(l.y, -6.0f, 8.0f);
                        const f32x2 t = g * (-1.702f * LOG2E); f32x2 e; e.x = __builtin_amdgcn_exp2f(t.x); e.y = __builtin_amdgcn_exp2f(t.y);
                        const f32x2 d = e + 1.0f; f32x2 sg; sg.x = __builtin_amdgcn_rcpf(d.x); sg.y = __builtin_amdgcn_rcpf(d.y);
                        const f32x2 r = (g * sg) * l; o[n][2 * hh] = r.x; o[n][2 * hh + 1] = r.y; }
                u32x2 w; w.x = pack4_fp8_nc(o[0]); w.y = pack4_fp8_nc(o[1]); *(u32x2*)((unsigned char*)act + row * DE + col) = w; }
    }
};

struct EpiDown {
    static constexpr bool HAS_MID = false, META = true;
    unsigned char* y; const float* b_out; const int* list; const LAS int* cnt;
    __device__ __forceinline__ void mid(f32x4 (&)[2][2][4][2], const Unit&, int, int, int, int) const {}
    __device__ __forceinline__ unsigned meta_issue(const Unit& u, int tid) const {
        if (tid < 256) return __builtin_bit_cast(unsigned, b_out[(size_t)u.e * D + u.pn * BM + tid]);
        const int nv = cnt[u.e] - u.mt * BM, r = tid - 256; return (unsigned)list[u.e * LISTCAP + u.mt * BM + (r < nv ? r : 0)];
    }
    __device__ __forceinline__ void meta_finish(unsigned bits, LAS unsigned char* buf, int tid) const { ((LAS unsigned*)buf)[tid] = bits; }
    __device__ __forceinline__ void run(const f32x4 (&acc)[2][2][4][2], const Unit& u, int wr, int wc, int fr, int fq, const LAS unsigned char* buf) const {
        const int cl = wc * 64 + 16 * fq, col = u.pn * BM + cl; const int nvalid = cnt[u.e] - u.mt * BM;
        f32x4 bv[2][2];
#pragma unroll
        for (int bj = 0; bj < 2; ++bj)
#pragma unroll
            for (int n = 0; n < 2; ++n) bv[bj][n] = *(const LAS f32x4*)(buf + (cl + 8 * bj + 4 * n) * 4);
#pragma unroll
        for (int ai = 0; ai < 2; ++ai)
#pragma unroll
            for (int m = 0; m < 4; ++m) { const int rl = ai * HALF + wr * 64 + m * 16 + fr; const int aid = ((const LAS int*)buf)[256 + rl]; u32x4 w;
#pragma unroll
                for (int bj = 0; bj < 2; ++bj)
#pragma unroll
                    for (int n = 0; n < 2; ++n) w[2 * bj + n] = pack4_fp8(acc[ai][bj][m][n] * WINV + bv[bj][n]);
                if (rl < nvalid) *(u32x4*)(y + (size_t)aid * D + col) = w; }
    }
};
}

struct XItem { const float* src; unsigned char* dst; };
__device__ __forceinline__ XItem xitem_decode(int r, const float* we1, unsigned char* W1, int lane) {
    const int kr = lane >> 3, n4 = lane & 7; const int e = r >> 9, q = r & 511, kb = q >> 6, nb = q & 63; const int n0 = 32 * nb, bj = n0 >> 10, j0 = n0 & 1023;
    const int drow = 256 * (j0 >> 7) + 64 * ((j0 >> 5) & 3) + 32 * bj; XItem d;
    d.src = we1 + (size_t)e * D * 2048 + (size_t)(128 * kb + 16 * kr) * 2048 + n0 + 4 * n4; d.dst = W1 + (size_t)e * 2048 * D + (size_t)(drow + 4 * n4) * D + 128 * kb + 16 * kr; return d;
}
__device__ __forceinline__ void xitem_load(const XItem& d, f32x4 (&v)[16]) {
#pragma unroll
    for (int i = 0; i < 16; ++i) v[i] = __builtin_nontemporal_load((const f32x4*)(d.src + (size_t)i * 2048));
}
__device__ __forceinline__ void xitem_store(const XItem& d, const f32x4 (&v)[16]) {
#pragma unroll
    for (int nn = 0; nn < 4; ++nn) { u32x4 o;
#pragma unroll
        for (int q = 0; q < 4; ++q) o[q] = pg8::pack4_fp8((f32x4){v[4 * q][nn], v[4 * q + 1][nn], v[4 * q + 2][nn], v[4 * q + 3][nn]} * pg8::WSCALE);
        __builtin_nontemporal_store(o, (u32x4*)(d.dst + (size_t)nn * D)); }
}

namespace att {
constexpr int NSLOT = 7, LEAD = NSLOT - 4, L_K = 0, L_V = NSLOT * 8192, L_TAB = 2 * NSLOT * 8192, L_WS = L_TAB + 2048, L_OST = L_WS + 2048, OST_STRIDE = 68, OST_BYTES = 16 * OST_STRIDE * 4;
__device__ __forceinline__ int crow(int r, int hi) { return (r & 3) + 8 * (r >> 2) + 4 * hi; }
__device__ __forceinline__ s16x4 vtr(const LAS char* p) { typedef short v4i16_t __attribute__((ext_vector_type(4))); return __builtin_bit_cast(s16x4, __builtin_amdgcn_ds_read_tr16_b64_v4i16((LAS v4i16_t*)p)); }

template <bool FULL>
__device__ __forceinline__ void attn_units(int b0, int bstep, int nunits, int h, int qb, const bf16_t* Q, const bf16_t* Kt, const bf16_t* Vt, bf16_t* MIX, float* ssq_att,
                                           const float* rel_bias, const float* MH, const float* g_att, LAS unsigned char* lds) {
    const int tid = opaque_tid(), lane = tid & 63, r32 = lane & 31, hi = lane >> 5; const int wid = __builtin_amdgcn_readfirstlane(tid >> 6);
    const int q0 = qb * 256;
    LAS float* dt = (LAS float*)(lds + L_TAB);
    const float mh = MH[h], bfar = rel_bias[h * 257 + 256];
    if (tid < 320) dt[319 - tid] = (rel_bias[h * 257 + (tid < 256 ? tid : 256)] - bfar) * LOG2E;
    const int base = 4 * qb - 8, o = wid >> 1, qo = 32 * (wid & 1);
    const int i0 = FULL ? 0 : (base + 3 < 0 ? -(base + 3) : 0);
    constexpr int NPK = FULL ? 4 + LEAD : 4, NPV = FULL ? 3 + LEAD : 4;
    const int ch = lane & 7;
    const f32x4 g0 = *(const f32x4*)(g_att + h * 64 + ch * 8), g1 = *(const f32x4*)(g_att + h * 64 + ch * 8 + 4);
    const bf16_t* Qw = Q + ((size_t)b0 * SEQ + q0 + wid * 32 + r32) * 512 + h * 64 + hi * 8;
    bf16x8 qr[4];
#pragma unroll
    for (int d0 = 0; d0 < 4; ++d0) qr[d0] = *(const bf16x8*)(Qw + d0 * 16);
    const bf16_t* ksrc = Kt + ((size_t)b0 * SEQ + lane) * 512 + h * 64 + wid * 8;
    const bf16_t* vsrc = Vt + ((size_t)b0 * SEQ + 16 * (wid & 3) + (lane >> 2)) * 512 + h * 64 + (wid >> 2) * 32 + (lane & 3) * 8;
    const size_t ustride = (size_t)bstep * SEQ * 512;
#define ATT_DMA_K(kp, t) do { const int sl_ = ((t) - base) % NSLOT; glds16((kp) + (size_t)(t) * 64 * 512, (unsigned)__builtin_amdgcn_readfirstlane(lds_addr(lds + L_K + sl_ * 8192 + wid * 1024))); } while (0)
#define ATT_DMA_V(vp_, t) do { const int sl_ = ((t) - base) % NSLOT; glds16((vp_) + (size_t)(t) * 64 * 512, (unsigned)__builtin_amdgcn_readfirstlane(lds_addr(lds + L_V + sl_ * 8192 + wid * 1024))); } while (0)
#define ATT_PROLOGUE(kp, vp_) do { _Pragma("unroll") for (int j = 0; j < NPK; ++j) { const int t = base + i0 + j; if (t >= 0 && t <= base + 11) ATT_DMA_K(kp, t); if (j < NPV && t >= 0) ATT_DMA_V(vp_, t); } } while (0)
    f32x16 cfv;
    { const float cfar = (bfar - mh) * LOG2E;
#pragma unroll
      for (int r = 0; r < 16; ++r) cfv[r] = cfar; }
#define ATT_QK(S0, S1, sl) do { const LAS char* kb = (const LAS char*)(lds + L_K + (sl) * 8192 + hi * 1024 + r32 * 16); \
        _Pragma("unroll") for (int d0 = 0; d0 < 4; ++d0) { \
            const bf16x8 k0 = *(const LAS bf16x8*)(kb + d0 * 2048), k1 = *(const LAS bf16x8*)(kb + d0 * 2048 + 512); \
            S0 = __builtin_amdgcn_mfma_f32_32x32x16_bf16(k0, qr[d0], d0 == 0 ? cfv : S0, 0, 0, 0); \
            S1 = __builtin_amdgcn_mfma_f32_32x32x16_bf16(k1, qr[d0], d0 == 0 ? cfv : S1, 0, 0, 0); } } while (0)
#define ATT_BIAS(S0, S1, delta) do { const int R0 = 319 - (64 * (delta) + qo + r32 + 128 - 4 * hi); \
        _Pragma("unroll") for (int r = 0; r < 16; ++r) { S0[r] += dt[R0 + (r & 3) + 8 * (r >> 2)]; S1[r] += dt[R0 + 32 + (r & 3) + 8 * (r >> 2)]; } } while (0)
#define ATT_SPV(S0, S1, sl) do { float sacc = 0.f; \
        _Pragma("unroll") for (int r = 0; r < 16; ++r) { S0[r] = __builtin_amdgcn_exp2f(S0[r]); S1[r] = __builtin_amdgcn_exp2f(S1[r]); sacc += S0[r] + S1[r]; } \
        l_reg += sacc; \
        u32x4 pw[4]; \
        _Pragma("unroll") for (int j = 0; j < 4; ++j) { pw[0][j] = cvt_pk_bf16(S0[2 * j], S0[2 * j + 1]); pw[1][j] = cvt_pk_bf16(S0[8 + 2 * j], S0[8 + 2 * j + 1]); \
                                                         pw[2][j] = cvt_pk_bf16(S1[2 * j], S1[2 * j + 1]); pw[3][j] = cvt_pk_bf16(S1[8 + 2 * j], S1[8 + 2 * j + 1]); } \
        const LAS char* vp = (const LAS char*)(lds + L_V + (sl) * 8192 + ((lane >> 4) & 1) * 32 + (lane & 3) * 8 + (4 * hi + ((lane & 15) >> 2)) * 64); \
        _Pragma("unroll") for (int ks = 0; ks < 4; ++ks) { \
            const s16x4 l0 = vtr(vp + ks * 1024), h0 = vtr(vp + ks * 1024 + 512), l1 = vtr(vp + 4096 + ks * 1024), h1 = vtr(vp + 4096 + ks * 1024 + 512); \
            const bf16x8 v0 = (bf16x8){l0[0], l0[1], l0[2], l0[3], h0[0], h0[1], h0[2], h0[3]}, v1 = (bf16x8){l1[0], l1[1], l1[2], l1[3], h1[0], h1[1], h1[2], h1[3]}; \
            const bf16x8 pa = __builtin_bit_cast(bf16x8, pw[ks]); \
            o0 = __builtin_amdgcn_mfma_f32_32x32x16_bf16(pa, v0, o0, 0, 0, 0); \
            o1 = __builtin_amdgcn_mfma_f32_32x32x16_bf16(pa, v1, o1, 0, 0, 0); } } while (0)
    ATT_PROLOGUE(ksrc, vsrc);
#pragma unroll 1
    for (int u = 0; u < nunits; ++u) {
    const bool has_next = u + 1 < nunits;
    const size_t rowbase = (size_t)(b0 + bstep * u) * SEQ;
    f32x16 o0 = {}, o1 = {}; float l_reg = 0.f;
    if constexpr (FULL) {
        static_assert(LEAD == 3, "the counted waits below are written for a lead of 3 steps");
#define ATT_TOP(i, W) do { asm volatile("s_waitcnt vmcnt(" #W ")" ::: "memory"); __syncthreads(); \
        if ((i) + 4 + LEAD <= 11) ATT_DMA_K(ksrc, base + (i) + 4 + LEAD); if ((i) + 3 + LEAD <= 11) ATT_DMA_V(vsrc, base + (i) + 3 + LEAD); } while (0)
#define ATT_BODY(i, C0, C1, N0, N1) do { \
        if ((i) >= 6) ATT_BIAS(C0, C1, 8 - (i)); \
        ATT_QK(N0, N1, ((i) + 1 + o) % NSLOT); ATT_SPV(C0, C1, ((i) + o) % NSLOT); } while (0)
        f32x16 sa0, sa1, sb0, sb1;
        asm volatile("s_waitcnt vmcnt(4)" ::: "memory");
        __syncthreads();
        ATT_QK(sa0, sa1, o);
#pragma unroll 1
        for (int i = 0; i < 8; i += 2) {
            if (i == 6) ATT_TOP(i, 3); else ATT_TOP(i, 4);
            ATT_BODY(i, sa0, sa1, sb0, sb1);
            if (i == 6) ATT_TOP(i + 1, 1); else ATT_TOP(i + 1, 4);
            ATT_BODY(i + 1, sb0, sb1, sa0, sa1);
        }
        ATT_TOP(8, 0);
        if (has_next) {
#pragma unroll
            for (int d0 = 0; d0 < 4; ++d0) qr[d0] = *(const bf16x8*)(Qw + ustride + d0 * 16); }
        ATT_BIAS(sa0, sa1, 0);
        ATT_SPV(sa0, sa1, (8 + o) % NSLOT);
#undef ATT_BODY
#undef ATT_TOP
    } else {
#pragma unroll 1
        for (int i = i0; i <= 8; ++i) {
            VM_WAIT();
            __syncthreads();
            if (i < 8) { ATT_DMA_K(ksrc, base + i + 4); ATT_DMA_V(vsrc, base + i + 4); }
            if (base + i + o >= 0) {
                const int slot = (i + o) % NSLOT;
                f32x16 p0, p1;
                ATT_QK(p0, p1, slot);
                if (i >= 6) ATT_BIAS(p0, p1, 8 - i);
                ATT_SPV(p0, p1, slot);
            }
        }
        if (has_next) {
#pragma unroll
            for (int d0 = 0; d0 < 4; ++d0) qr[d0] = *(const bf16x8*)(Qw + ustride + d0 * 16); }
    }
    __syncthreads();
    Qw += ustride; ksrc += ustride; vsrc += ustride;
    if (has_next) ATT_PROLOGUE(ksrc, vsrc);
#undef ATT_DMA_K
#undef ATT_DMA_V
#undef ATT_PROLOGUE
#undef ATT_QK
#undef ATT_BIAS
#undef ATT_SPV
    l_reg += __shfl_xor(l_reg, 32);
    LAS float* wsf = (LAS float*)(lds + L_WS) + wid * 32;
    if (hi == 0) wsf[r32] = l_reg;
    LDS_WAIT();
    LAS float* stg = (LAS float*)(lds + L_OST + wid * OST_BYTES);
#pragma unroll
    for (int p = 0; p < 2; ++p) {
#pragma unroll
        for (int r = 8 * p; r < 8 * p + 8; ++r) { const int orow = crow(r, hi); const float rl = __builtin_amdgcn_rcpf(wsf[orow]);
            stg[(orow - 16 * p) * OST_STRIDE + r32] = o0[r] * rl; stg[(orow - 16 * p) * OST_STRIDE + 32 + r32] = o1[r] * rl; }
        LDS_WAIT();
#pragma unroll
        for (int i = 0; i < 2; ++i) { const int row = i * 8 + (lane >> 3);
            const f32x4 a = *(const LAS f32x4*)(stg + row * OST_STRIDE + ch * 8), bq = *(const LAS f32x4*)(stg + row * OST_STRIDE + ch * 8 + 4);
            float ss = (a[0] * a[0] + a[1] * a[1]) + (a[2] * a[2] + a[3] * a[3]) + (bq[0] * bq[0] + bq[1] * bq[1]) + (bq[2] * bq[2] + bq[3] * bq[3]);
            ss += __shfl_xor(ss, 1); ss += __shfl_xor(ss, 2); ss += __shfl_xor(ss, 4);
            const size_t tok = rowbase + q0 + wid * 32 + 16 * p + row;
            if (ch == 0) ssq_att[tok * 8 + h] = ss;
            *(u32x4*)(MIX + tok * D + h * 64 + ch * 8) = pg8::pack8(a * g0, bq * g1); }
        LDS_WAIT();
    }
    }
    __syncthreads();
}
}

namespace gm {
constexpr int L_RS = 131072, L_BS = 131072 + 2048;
__device__ __forceinline__ void gmlp_unit(int b, int blk, const bf16_t* GU, const bf16_t* GV, const float* ssq_gv, const bf16_t* wsb, const float* b_s, const float* gvn, const float* g_out,
                                          bf16_t* MIX, LAS unsigned char* lds) {
    const int tid = opaque_tid(), lane = tid & 63, r32 = lane & 31, hi = lane >> 5; const int wid = __builtin_amdgcn_readfirstlane(tid >> 6);
    const size_t t0 = (size_t)b * SEQ + (size_t)blk * 128;
    LAS float* bsl = (LAS float*)(lds + L_BS);
    {
        const int js = 16 * wid + (lane >> 2);
        const bf16_t* src = GV + (t0 + js) * 512 + (lane & 3) * 8;
        u32x4 vt[16];
#pragma unroll
        for (int i = 0; i < 16; ++i) vt[i] = *(const u32x4*)(src + i * 32);
        const f32x4 qa = *(const f32x4*)(ssq_gv + (t0 + js) * 8), qb_ = *(const f32x4*)(ssq_gv + (t0 + js) * 8 + 4);
        float rsg[4];
        rsg[0] = __builtin_amdgcn_rsqf((qa[0] + qa[1]) * (1.0f / 128.0f) + EPS); rsg[1] = __builtin_amdgcn_rsqf((qa[2] + qa[3]) * (1.0f / 128.0f) + EPS);
        rsg[2] = __builtin_amdgcn_rsqf((qb_[0] + qb_[1]) * (1.0f / 128.0f) + EPS); rsg[3] = __builtin_amdgcn_rsqf((qb_[2] + qb_[3]) * (1.0f / 128.0f) + EPS);
        bsl[tid] = b_s[tid];
#pragma unroll
        for (int i = 0; i < 16; ++i) { const float r_ = rsg[i >> 2]; u32x4 w_;
#pragma unroll
            for (int k = 0; k < 4; ++k) w_[k] = cvt_pk_bf16(__builtin_bit_cast(float, vt[i][k] << 16) * r_, __builtin_bit_cast(float, vt[i][k] & 0xffff0000u) * r_);
            *(LAS u32x4*)(lds + i * 8192 + wid * 1024 + lane * 16) = w_; }
    }
    __syncthreads();
    const int g = wid >> 1, chh = wid & 1;
    f32x16 acc[4][2];
#pragma unroll
    for (int ib = 0; ib < 4; ++ib) { acc[ib][0] = (f32x16){}; acc[ib][1] = (f32x16){}; }
    const LAS char* vp = (const LAS char*)(lds + (g * 4 + 2 * chh) * 8192 + ((lane >> 4) & 1) * 32 + (lane & 3) * 8 + (4 * hi + ((lane & 15) >> 2)) * 64);
    const u32x4* wp = (const u32x4*)(wsb + ((size_t)(g * 128 + r32) * 128 + 8 * hi));
    u32x4 wf[8][4];
#define GM_WLOAD(s_) do { _Pragma("unroll") for (int ib = 0; ib < 4; ++ib) { if (ib < 2 && (s_) >= 4) continue; wf[s_][ib] = wp[(32 * ib * 128 + 16 * (s_)) / 8]; } } while (0)
    GM_WLOAD(0); GM_WLOAD(1);
#pragma unroll
    for (int s = 0; s < 8; ++s) {
        if (s + 2 < 8) GM_WLOAD(s + 2);
        const s16x4 l0 = att::vtr(vp + s * 1024), h0 = att::vtr(vp + s * 1024 + 512), l1 = att::vtr(vp + 8192 + s * 1024), h1 = att::vtr(vp + 8192 + s * 1024 + 512);
        const bf16x8 v0 = (bf16x8){l0[0], l0[1], l0[2], l0[3], h0[0], h0[1], h0[2], h0[3]}, v1 = (bf16x8){l1[0], l1[1], l1[2], l1[3], h1[0], h1[1], h1[2], h1[3]};
#pragma unroll
        for (int ib = 0; ib < 4; ++ib) {
            if (ib < 2 && s >= 4) continue;
            const bf16x8 af = __builtin_bit_cast(bf16x8, wf[s][ib]);
            acc[ib][0] = __builtin_amdgcn_mfma_f32_32x32x16_bf16(af, v0, acc[ib][0], 0, 0, 0);
            acc[ib][1] = __builtin_amdgcn_mfma_f32_32x32x16_bf16(af, v1, acc[ib][1], 0, 0, 0);
        }
        asm volatile("" ::: "memory");
    }
#undef GM_WLOAD
    u32x4 uu[16];
#pragma unroll
    for (int rr = 0; rr < 16; ++rr) uu[rr] = *(const u32x4*)(GU + (t0 + 16 * wid + rr) * 512 + 8 * lane);
    __syncthreads();
    {
        const float gn0 = gvn[g * 128 + 64 * chh + r32], gn1 = gvn[g * 128 + 64 * chh + 32 + r32];
        LAS bf16_t* stg = (LAS bf16_t*)lds;
#pragma unroll
        for (int ib = 0; ib < 4; ++ib)
#pragma unroll
            for (int r = 0; r < 16; ++r) { const int i = 32 * ib + att::crow(r, hi); const float bb = bsl[g * 128 + i];
                const unsigned pk = cvt_pk_bf16(acc[ib][0][r] * gn0 + bb, acc[ib][1][r] * gn1 + bb);
                stg[i * 512 + g * 128 + 64 * chh + r32] = (bf16_t)(pk & 0xffffu); stg[i * 512 + g * 128 + 64 * chh + 32 + r32] = (bf16_t)(pk >> 16); }
    }
    __syncthreads();
    {
        const f32x4 go0 = *(const f32x4*)(g_out + 8 * lane), go1 = *(const f32x4*)(g_out + 8 * lane + 4);
#pragma unroll
        for (int rr = 0; rr < 16; ++rr) { const int i = 16 * wid + rr;
            const u32x4 gt = *(const LAS u32x4*)(lds + (size_t)i * 1024 + lane * 16);
            float v[8];
#pragma unroll
            for (int k = 0; k < 4; ++k) { v[2 * k] = __builtin_bit_cast(float, gt[k] << 16) * __builtin_bit_cast(float, uu[rr][k] << 16);
                                           v[2 * k + 1] = __builtin_bit_cast(float, gt[k] & 0xffff0000u) * __builtin_bit_cast(float, uu[rr][k] & 0xffff0000u); }
            float ss = 0.f;
#pragma unroll
            for (int k = 0; k < 8; ++k) ss += v[k] * v[k];
            ss = wave_sum(ss);
            const float rs = __builtin_amdgcn_rsqf(ss * (1.0f / 512.0f) + EPS);
            const f32x4 a = (f32x4){v[0], v[1], v[2], v[3]} * rs * go0, c = (f32x4){v[4], v[5], v[6], v[7]} * rs * go1;
            *(u32x4*)(MIX + (t0 + i) * D + 512 + 8 * lane) = pg8::pack8(a, c); }
    }
    __syncthreads();
}
}

#define XB_TMO      128
#define XB_XCNT(j)  (256  + 64 * (j))
#define XB_XSUB(j)  (1280 + 64 * (j))
#define XB_XGEN(j)  (2304 + 64 * (j))
#define XB_TOP      3328
#define XB_TOPGEN   3392
#define XCD_BAR_WORDS 3456
#define XB_SPIN_CAP (1u << 18)
__device__ __forceinline__ unsigned xb_ld(unsigned* p)              { return __hip_atomic_load(p, __ATOMIC_RELAXED, __HIP_MEMORY_SCOPE_AGENT); }
__device__ __forceinline__ unsigned xb_add(unsigned* p, unsigned v) { return __hip_atomic_fetch_add(p, v, __ATOMIC_RELAXED, __HIP_MEMORY_SCOPE_AGENT); }
__device__ __forceinline__ unsigned xb_xcc_id() { return (unsigned)__builtin_amdgcn_s_getreg((3 << 11) | 20) & 0xFu; }
#define XB_SPIN(cond, bar) do { unsigned _sp = 0; while (cond) { __builtin_amdgcn_s_sleep(1); \
    if ((++_sp & 255u) == 0u) { if (xb_ld(&(bar)[XB_TMO])) break; if (_sp > XB_SPIN_CAP) { atomicAdd(&(bar)[XB_TMO], 1u); break; } } } } while (0)
struct XcdBarrier { unsigned* bar; unsigned x; volatile LAS unsigned* st; };
__device__ __forceinline__ XcdBarrier xcd_barrier_post(unsigned* bar, volatile LAS unsigned* st) {
    XcdBarrier b; b.bar = bar; b.x = xb_xcc_id(); b.st = st;
    if (threadIdx.x == 0) (void)xb_add(&bar[XB_XCNT(b.x)], 1u);
    return b;
}
__device__ __forceinline__ void xcd_barrier_complete(unsigned* bar, unsigned x, unsigned& nloc, unsigned& nx) {
    const unsigned G = gridDim.x * gridDim.y * gridDim.z;
    unsigned sum, cnt, mine, sp = 0u;
    for (;;) {
        sum = 0u; cnt = 0u; mine = 0u;
#pragma unroll
        for (unsigned j = 0; j < 16; ++j) { const unsigned c = xb_ld(&bar[XB_XCNT(j)]); sum += c; cnt += (c > 0u) ? 1u : 0u; mine = (j == x) ? c : mine; }
        if (sum == G) break;
        __builtin_amdgcn_s_sleep(1);
        if ((++sp & 255u) == 0u) { if (xb_ld(&bar[XB_TMO])) break; if (sp > XB_SPIN_CAP) { atomicAdd(&bar[XB_TMO], 1u); break; } }
    }
    nloc = mine > 0u ? mine : 1u; nx = cnt > 0u ? cnt : 1u;
}
__device__ __forceinline__ void xcd_barrier(const XcdBarrier& b) {
    asm volatile("s_waitcnt vmcnt(0)" ::: "memory");
    __syncthreads();
    if (threadIdx.x == 0) {
        unsigned* bar = b.bar;
        __builtin_amdgcn_s_waitcnt(0);
        unsigned nloc = b.st[0], nx = b.st[1];
        if (nloc == 0u) { xcd_barrier_complete(bar, b.x, nloc, nx); b.st[0] = nloc; b.st[1] = nx; }
        const unsigned old = xb_add(&bar[XB_XSUB(b.x)], 1u);
        const unsigned gen = old / nloc;
        if (old + 1u == (gen + 1u) * nloc) {
            __builtin_amdgcn_fence(__ATOMIC_RELEASE, "agent");
            asm volatile("s_waitcnt vmcnt(0)" ::: "memory");
            const unsigned og = xb_add(&bar[XB_TOP], 1u);
            const unsigned tg = og / nx;
            if (og + 1u == (tg + 1u) * nx) xb_add(&bar[XB_TOPGEN], 1u);
            else XB_SPIN(xb_ld(&bar[XB_TOPGEN]) == tg, bar);
            __builtin_amdgcn_fence(__ATOMIC_ACQUIRE, "agent");
            xb_add(&bar[XB_XGEN(b.x)], 1u);
            asm volatile("s_waitcnt vmcnt(0)" ::: "memory");
        } else {
            XB_SPIN(xb_ld(&bar[XB_XGEN(b.x)]) == gen, bar);
            __builtin_amdgcn_fence(__ATOMIC_ACQUIRE, "agent");
            asm volatile("s_waitcnt vmcnt(0)" ::: "memory");
        }
    }
    __syncthreads();
}

struct Args { const float* in[19]; float* out; unsigned char* ws; int ph_lo, ph_hi; };
enum { I_X = 0, I_GMIX, I_WIN, I_QG, I_KG, I_RELB, I_GVN, I_WS, I_BS, I_GATT, I_GGM, I_WOUT, I_GMOE, I_WR, I_BR, I_WE1, I_BE1, I_WE2, I_BE2 };

template <int KT, bool FP8OUT>
__device__ __forceinline__ void transpose_item(const float* W, int K, int N, void* WT, int dst_row0, int k0, int n0, float scale, int lane) {
    constexpr int KL = KT / 8;
    static_assert((FP8OUT && KL == 16) || (!FP8OUT && KL == 8), "16 bytes per lane and column");
    f32x4 v[KL];
    const int kr = lane >> 3, n4 = lane & 7;
    const float* src = W + (size_t)(k0 + KL * kr) * N + n0 + 4 * n4;
#pragma unroll
    for (int i = 0; i < KL; ++i) v[i] = __builtin_nontemporal_load((const f32x4*)(src + (size_t)i * N));
#pragma unroll
    for (int nn = 0; nn < 4; ++nn) {
        u32x4 o;
        if constexpr (FP8OUT) {
#pragma unroll
            for (int q = 0; q < 4; ++q) o[q] = pg8::pack4_fp8((f32x4){v[4 * q][nn], v[4 * q + 1][nn], v[4 * q + 2][nn], v[4 * q + 3][nn]} * scale);
            __builtin_nontemporal_store(o, (u32x4*)((unsigned char*)WT + (size_t)(dst_row0 + 4 * n4 + nn) * K + k0 + 16 * kr));
        } else {
#pragma unroll
            for (int q = 0; q < 4; ++q) o[q] = cvt_pk_bf16(v[2 * q][nn], v[2 * q + 1][nn]);
            *(u32x4*)((bf16_t*)WT + (size_t)(dst_row0 + 4 * n4 + nn) * K + k0 + 8 * kr) = o;
        }
    }
}

__device__ __forceinline__ void p4_router(LAS unsigned char* lds, const float* x, const bf16_t* MO, bf16_t* HB, float* GATES, int* LIST, unsigned* ECNT,
                                          const float* gmoe, const float* wr, const float* br, int G, int bx, const float* we1, unsigned char* W1c) {
    const int tid = opaque_tid(), lane = tid & 63; const int wid = __builtin_amdgcn_readfirstlane(tid >> 6);
    LAS unsigned short* whi = (LAS unsigned short*)lds; LAS unsigned short* wlo = (LAS unsigned short*)(lds + 32 * 2064);
    LAS float* part = (LAS float*)(lds + 132096);
    LAS int* lcnt = (LAS int*)(lds + LDS_LCNT);
    LAS float* ssqp = (LAS float*)(lds + LDS_LCNT + 256);
    LAS float* rsl = (LAS float*)(lds + LDS_LCNT + 768);
    LAS unsigned short* sel = (LAS unsigned short*)(lds + LDS_PT);
    {
        f32x4 wv[16]; float gk[16];
#pragma unroll
        for (int i = 0; i < 16; ++i) { const int idx4 = tid + 512 * i; wv[i] = *((const f32x4*)wr + idx4); gk[i] = gmoe[idx4 >> 3]; }
#pragma unroll
        for (int i = 0; i < 16; ++i) { const int idx4 = tid + 512 * i, k = idx4 >> 3, e0 = (idx4 & 7) * 4;
#pragma unroll
            for (int c = 0; c < 4; ++c) { const float v = wv[i][c] * gk[i];
                const unsigned hi = cvt_pk_bf16(v, 0.f) & 0xffffu; const float r = v - __builtin_bit_cast(float, hi << 16);
                whi[(e0 + c) * 1032 + k] = (unsigned short)hi; wlo[(e0 + c) * 1032 + k] = (unsigned short)(cvt_pk_bf16(r, 0.f) & 0xffffu); } }
    }
    if (tid < 32) lcnt[tid] = 0;
    __syncthreads();
    const int tt = lane & 15, q = lane >> 4, kb = 128 * wid + 8 * q;
    f32x4 gg[8];
#pragma unroll
    for (int s = 0; s < 4; ++s) { gg[2 * s] = *(const f32x4*)(gmoe + kb + 32 * s); gg[2 * s + 1] = *(const f32x4*)(gmoe + kb + 32 * s + 4); }
    const f32x4 b0 = *(const f32x4*)(br + 4 * q), b1 = *(const f32x4*)(br + 16 + 4 * q);
    const int nr = (T / 16 - bx + G - 1) / G;
    u32x4 ma[4], mb[4];
    XItem xd; f32x4 xw[16];
#define P4_LOAD(jr, MV) do { const size_t ro_ = (size_t)(16 * (bx + (jr) * G) + tt) * D + kb; \
        _Pragma("unroll") for (int s = 0; s < 4; ++s) { MV[s] = __builtin_nontemporal_load((const u32x4*)(MO + ro_ + 32 * s)); } } while (0)
    if (nr > 0) P4_LOAD(0, ma);
    if (nr > 1) P4_LOAD(1, mb);
    if (nr > 0) { xd = xitem_decode(8192 + bx * 8 + wid, we1, W1c, lane); xitem_load(xd, xw); }
#define P4_ROUND(j, MV, ITEM) do { \
        const int tb = 16 * (bx + j * G); \
        f32x4 hv[8]; float ssq = 0.f; \
_Pragma("unroll") \
        for (int s = 0; s < 4; ++s) { \
            hv[2 * s] = (f32x4){__builtin_bit_cast(float, MV[s][0] << 16), __builtin_bit_cast(float, MV[s][0] & 0xffff0000u), __builtin_bit_cast(float, MV[s][1] << 16), __builtin_bit_cast(float, MV[s][1] & 0xffff0000u)}; \
            hv[2 * s + 1] = (f32x4){__builtin_bit_cast(float, MV[s][2] << 16), __builtin_bit_cast(float, MV[s][2] & 0xffff0000u), __builtin_bit_cast(float, MV[s][3] << 16), __builtin_bit_cast(float, MV[s][3] & 0xffff0000u)}; } \
_Pragma("unroll") \
        for (int s = 0; s < 8; ++s) ssq += (hv[s][0] * hv[s][0] + hv[s][1] * hv[s][1]) + (hv[s][2] * hv[s][2] + hv[s][3] * hv[s][3]); \
        if (j + 2 < nr) { const size_t ro = (size_t)(16 * (bx + (j + 2) * G) + tt) * D + kb; \
_Pragma("unroll") \
            for (int s = 0; s < 4; ++s) { MV[s] = __builtin_nontemporal_load((const u32x4*)(MO + ro + 32 * s)); } } \
        f32x4 a0 = {0.f, 0.f, 0.f, 0.f}, a1 = {0.f, 0.f, 0.f, 0.f}; \
        const LAS unsigned char* w0p = (const LAS unsigned char*)whi + tt * 2064 + kb * 2; \
_Pragma("unroll") \
        for (int s = 0; s < 4; ++s) { \
            u32x4 hh, hl; \
_Pragma("unroll") \
            for (int c = 0; c < 2; ++c) \
_Pragma("unroll") \
                for (int d = 0; d < 2; ++d) { const float f0 = hv[2 * s + c][2 * d], f1 = hv[2 * s + c][2 * d + 1]; const unsigned ph = cvt_pk_bf16(f0, f1); \
                    hh[2 * c + d] = ph; hl[2 * c + d] = cvt_pk_bf16(f0 - __builtin_bit_cast(float, ph << 16), f1 - __builtin_bit_cast(float, ph & 0xffff0000u)); } \
            const bf16x8 bh = __builtin_bit_cast(bf16x8, hh), bl = __builtin_bit_cast(bf16x8, hl); \
            const bf16x8 w0h = *(const LAS bf16x8*)(w0p + 64 * s), w1h = *(const LAS bf16x8*)(w0p + 16 * 2064 + 64 * s); \
            const bf16x8 w0l = *(const LAS bf16x8*)(w0p + 32 * 2064 + 64 * s), w1l = *(const LAS bf16x8*)(w0p + 48 * 2064 + 64 * s); \
            a0 = __builtin_amdgcn_mfma_f32_16x16x32_bf16(w0h, bh, a0, 0, 0, 0); a1 = __builtin_amdgcn_mfma_f32_16x16x32_bf16(w1h, bh, a1, 0, 0, 0); \
            a0 = __builtin_amdgcn_mfma_f32_16x16x32_bf16(w0h, bl, a0, 0, 0, 0); a1 = __builtin_amdgcn_mfma_f32_16x16x32_bf16(w1h, bl, a1, 0, 0, 0); \
            a0 = __builtin_amdgcn_mfma_f32_16x16x32_bf16(w0l, bh, a0, 0, 0, 0); a1 = __builtin_amdgcn_mfma_f32_16x16x32_bf16(w1l, bh, a1, 0, 0, 0); \
        } \
        ssq += __shfl_xor(ssq, 16); ssq += __shfl_xor(ssq, 32); \
        if (q == 0) ssqp[wid * 16 + tt] = ssq; \
        if (wid >= 4) { *(LAS f32x4*)(part + (wid - 4) * 512 + lane * 8) = a0; *(LAS f32x4*)(part + (wid - 4) * 512 + lane * 8 + 4) = a1; } \
        __syncthreads(); \
        if (wid < 4) { \
            a0 += *(const LAS f32x4*)(part + wid * 512 + lane * 8); a1 += *(const LAS f32x4*)(part + wid * 512 + lane * 8 + 4); \
            if (wid > 0) { *(LAS f32x4*)(part + wid * 512 + lane * 8) = a0; *(LAS f32x4*)(part + wid * 512 + lane * 8 + 4) = a1; } \
        } \
        __syncthreads(); \
        if (wid == 0) { \
_Pragma("unroll") \
            for (int p = 1; p < 4; ++p) { a0 += *(const LAS f32x4*)(part + p * 512 + lane * 8); a1 += *(const LAS f32x4*)(part + p * 512 + lane * 8 + 4); } \
            float st = 0.f; \
_Pragma("unroll") \
            for (int w = 0; w < 8; ++w) st += ssqp[w * 16 + tt]; \
            const float rs = __builtin_amdgcn_rsqf(st * (1.0f / D) + EPS); \
            if (q == 0) rsl[tt] = rs; \
            LAS float* lg = part + 4 * 512; \
_Pragma("unroll") \
            for (int r = 0; r < 4; ++r) { lg[tt * 33 + 4 * q + r] = a0[r] * rs + b0[r]; lg[tt * 33 + 16 + 4 * q + r] = a1[r] * rs + b1[r]; } \
        } \
        __syncthreads(); \
        { \
            const LAS float* lg = part + 4 * 512; const int half = lane >> 5, tk = 2 * wid + half, ee = lane & 31; \
            float v = lg[tk * 33 + ee]; float tv[4]; int se[4]; \
_Pragma("unroll") \
            for (int p = 0; p < 4; ++p) { \
                float m = v; \
_Pragma("unroll") \
                for (int o = 1; o < 32; o <<= 1) m = fmaxf(m, __shfl_xor(m, o)); \
                const unsigned long long bal = __ballot(v == m); \
                const unsigned hb32 = half ? (unsigned)(bal >> 32) : (unsigned)bal; \
                const int bi = __builtin_ctz(hb32); \
                tv[p] = m; se[p] = bi; if (ee == bi) v = -3.0e38f; \
            } \
            if (ee == 0) { \
                float ex[4], sum = 0.f; \
_Pragma("unroll") \
                for (int p = 0; p < 4; ++p) { ex[p] = __builtin_amdgcn_exp2f((tv[p] - tv[0]) * LOG2E); sum += ex[p]; } \
                const float inv = 1.0f / sum; \
                *(f32x4*)(GATES + (size_t)(tb + tk) * 4) = (f32x4){ex[0] * inv, ex[1] * inv, ex[2] * inv, ex[3] * inv}; \
_Pragma("unroll") \
                for (int p = 0; p < 4; ++p) { const int pos = __hip_atomic_fetch_add(&lcnt[se[p]], 1, __ATOMIC_RELAXED, __HIP_MEMORY_SCOPE_WORKGROUP); sel[(j * 16 + tk) * 4 + p] = (unsigned short)((se[p] << 9) | pos); } \
            } \
        } \
        { \
            const float rr = rsl[tt]; unsigned char* hb = (unsigned char*)HB + (size_t)(tb + tt) * D + kb; \
_Pragma("unroll") \
            for (int s = 0; s < 4; ++s) { u32x2 w; w.x = pg8::pack4_fp8(hv[2 * s] * rr * gg[2 * s]); w.y = pg8::pack4_fp8(hv[2 * s + 1] * rr * gg[2 * s + 1]); *(u32x2*)(hb + 32 * s) = w; } \
        } \
        if (ITEM) { xitem_store(xd, xw); if (j + 2 < nr) { xd = xitem_decode(8192 + ((j >> 1) + 1) * 2048 + bx * 8 + wid, we1, W1c, lane); xitem_load(xd, xw); } } \
    } while (0)
    for (int j = 0; j < nr; j += 2) {
        P4_ROUND(j, ma, true);
        const int j1 = j + 1;
        if (j1 < nr) P4_ROUND(j1, mb, false);
    }
#undef P4_ROUND
#undef P4_LOAD
    __syncthreads();
    if (tid < 32) lcnt[32 + tid] = (int)__hip_atomic_fetch_add(ECNT + tid, (unsigned)lcnt[tid], __ATOMIC_RELAXED, __HIP_MEMORY_SCOPE_AGENT);
    __syncthreads();
    if (tid < nr * 64) { const unsigned sv = sel[tid]; const int e = sv >> 9, pos = sv & 511; const int jr = tid >> 6, tl = (tid >> 2) & 15, kk = tid & 3;
        LIST[e * LISTCAP + lcnt[32 + e] + pos] = (16 * (bx + jr * G) + tl) * 4 + kk; }
    __syncthreads();
}

__global__ void __launch_bounds__(512, 2) fwd_kernel(Args args) {
    extern __shared__ __attribute__((aligned(16))) unsigned char lds_raw[];
    LAS unsigned char* lds = (LAS unsigned char*)lds_raw;
    const int tid = threadIdx.x, lane = tid & 63; const int wid = __builtin_amdgcn_readfirstlane(tid >> 6);
    const int G = gridDim.x, bx = blockIdx.x;
    const int vcu = (G % 8 == 0) ? (bx % 8) * (G / 8) + bx / 8 : bx;
    unsigned char* ws = args.ws;
    unsigned* ctl = (unsigned*)(ws + WS_CTL);
    volatile LAS unsigned* MISC = (volatile LAS unsigned*)(lds + LDS_MISC);
    if (tid < 64) MISC[tid] = 0u;
    __syncthreads();
    XcdBarrier bar; bar.bar = ctl + CW_BAR; bar.x = 0; bar.st = nullptr;
#if !MK_SPLIT
    bar = xcd_barrier_post(ctl + CW_BAR, MISC + 8);
#define GRID_BAR() xcd_barrier(bar)
#else
#define GRID_BAR() do {} while (0)
#endif
    const int lo = args.ph_lo, hi_ph = args.ph_hi;
#define IN(k) (lo <= (k) && (k) < hi_ph)
#define BOTH(k) (IN(k) && IN((k) + 1))
    const float* x = args.in[I_X]; float* out = args.out;
    bf16_t* WIN = (bf16_t*)(ws + WS_WIN); bf16_t* WO = (bf16_t*)(ws + WS_WO); bf16_t* W1 = (bf16_t*)(ws + WS_W1); bf16_t* W2 = (bf16_t*)(ws + WS_W2);
    bf16_t* HB = (bf16_t*)(ws + WS_HB); bf16_t* XB = (bf16_t*)(ws + WS_XB); bf16_t* QB = (bf16_t*)(ws + WS_Q); bf16_t* MIX = (bf16_t*)(ws + WS_MIX);
    bf16_t* ACT = (bf16_t*)(ws + WS_ACT); unsigned char* Y = ws + WS_Y; bf16_t* MO = (bf16_t*)(ws + WS_MO);
    float* SSQGV = (float*)(ws + WS_SSQGV); float* SSQAT = (float*)(ws + WS_SSQAT); float* GATES = (float*)(ws + WS_GATES); float* MHp = (float*)(ws + WS_MH); bf16_t* WSB = (bf16_t*)(ws + WS_WSB);
    int* LIST = (int*)(ws + WS_LIST); unsigned* ECNT = ctl + CW_ECNT;
    const int gw = vcu * 8 + wid, NGW = G * 8;

    if (IN(0)) for (int rep = 0; rep < NREP(0); ++rep) {
        if (rep) GRID_BAR();
        constexpr int I_IN = 16 * 80, I_O = 16 * 32, I_1 = 8 * 64, I_2 = 8 * 32;
        constexpr int NITEMS = I_IN + I_O;
        for (int it = gw; it < NITEMS; it += NGW) {
            int r = it;
            if (r < I_IN) { const int kb = r / 80, nb = r % 80; transpose_item<64, false>(args.in[I_WIN], D, NPROJ, WIN, 32 * nb, 64 * kb, 32 * nb, 1.0f, lane); continue; } r -= I_IN;
            { const int kb = r / 32, nb = r % 32; transpose_item<64, false>(args.in[I_WOUT], D, D, WO, 32 * nb, 64 * kb, 32 * nb, 1.0f, lane); }
        }
        { const float* gmix = args.in[I_GMIX];
          f32x4 gg[4];
#pragma unroll
          for (int j = 0; j < 4; ++j) gg[j] = *(const f32x4*)(gmix + 4 * lane + 256 * j);
          for (int m0 = gw; m0 < T; m0 += 4 * NGW) {
              f32x4 v[4][4]; float ss[4];
#pragma unroll
              for (int r = 0; r < 4; ++r) { const int m = m0 + r * NGW < T ? m0 + r * NGW : m0; const f32x4* xr = (const f32x4*)(x + (size_t)m * D) + lane;
#pragma unroll
                  for (int j = 0; j < 4; ++j) v[r][j] = __builtin_nontemporal_load(xr + 64 * j); }
#pragma unroll
              for (int r = 0; r < 4; ++r) { float s = 0.f;
#pragma unroll
                  for (int j = 0; j < 4; ++j) s += (v[r][j][0] * v[r][j][0] + v[r][j][1] * v[r][j][1]) + (v[r][j][2] * v[r][j][2] + v[r][j][3] * v[r][j][3]);
                  ss[r] = s; }
#pragma unroll
              for (int o = 1; o < 64; o <<= 1) {
#pragma unroll
                  for (int r = 0; r < 4; ++r) ss[r] += __shfl_xor(ss[r], o); }
#pragma unroll
              for (int r = 0; r < 4; ++r) { const int m = m0 + r * NGW; if (m < T) { const float rs = __builtin_amdgcn_rsqf(ss[r] * (1.0f / D) + EPS); u32x2* o8 = (u32x2*)(XB + (size_t)m * D) + lane;
#pragma unroll
                  for (int j = 0; j < 4; ++j) { const f32x4 z = v[r][j] * rs * gg[j]; u32x2 w; w.x = cvt_pk_bf16(z[0], z[1]); w.y = cvt_pk_bf16(z[2], z[3]); o8[64 * j] = w; } } }
          } }
        if (bx < 8 && wid == 0) {
            const int h = bx; const float* rb = args.in[I_RELB] + h * 257;
            float bv[5];
#pragma unroll
            for (int i = 0; i < 5; ++i) { const int idx = lane + 64 * i; bv[i] = rb[idx < 257 ? idx : 256]; }
            const float qv = fabsf(args.in[I_QG][lane]), kv = fabsf(args.in[I_KG][lane]);
            float mb = fmaxf(fmaxf(fmaxf(bv[0], bv[1]), fmaxf(bv[2], bv[3])), bv[4]);
            mb = wave_max(mb); const float mq = wave_max(qv), mk = wave_max(kv);
            if (lane == 0) MHp[h] = 8.0f * mq * mk + mb;
        }
        if (bx >= 8 && bx < 136) {
            const int idx = (bx - 8) * 512 + tid, jj = idx & 127, s_ = jj >> 4, hi_ = (jj >> 3) & 1, e_ = jj & 7;
            const int j = 16 * s_ + (e_ < 4 ? 4 * hi_ + e_ : 8 + 4 * hi_ + (e_ - 4));
            WSB[idx] = (bf16_t)(cvt_pk_bf16(args.in[I_WS][(idx & ~127) + j], 0.f) & 0xffffu);
        }
        __syncthreads();
        if (BOTH(0)) GRID_BAR();
    }

#define P1_BODY() do { pg8::DenseSched S; S.o.init(T / 256, NPROJ / 256, G, bx); S.A = (const char*)XB; S.Bt = (const char*)WIN; \
        pg8::EpiInProj E{QB, args.in[I_QG], args.in[I_KG], SSQGV}; \
        pg8::gemm_phase<pg8::EpiInProj, pg8::DenseSched, true, true>(lds, S, E); } while (0)
    if (IN(1)) {
        P1_BODY();
#if PROBE_REP == 1
        GRID_BAR(); P1_BODY();
#endif
        if (BOTH(1)) GRID_BAR();
    }

#define P2A_BODY() do { const int qb = bx & 15, h = (bx >> 4) & 7, b0 = bx >> 7; \
        if (qb >= 2) att::attn_units<true>(b0, 2, 4, h, qb, QB, QB + QSTRIDE, QB + 2 * QSTRIDE, MIX, SSQAT, args.in[I_RELB], MHp, args.in[I_GATT], lds); \
        else att::attn_units<false>(b0, 2, 4, h, qb, QB, QB + QSTRIDE, QB + 2 * QSTRIDE, MIX, SSQAT, args.in[I_RELB], MHp, args.in[I_GATT], lds); } while (0)
#define P2G_BODY() do { for (int u = bx; u < 256; u += G) \
                gm::gmlp_unit(u >> 5, u & 31, QB + 3 * QSTRIDE, QB + 4 * QSTRIDE, SSQGV, WSB, args.in[I_BS], args.in[I_GVN], args.in[I_GGM], MIX, lds); } while (0)
    if (IN(2)) {
        P2A_BODY();
#if PROBE_REP == 2
        P2A_BODY();
#endif
        for (int rep = 0; rep < NREP(9); ++rep) P2G_BODY();
        if (BOTH(2)) GRID_BAR();
    }

#define P3_BODY() do { pg8::DenseSched S; S.o.init(T / 256, D / 256, G, bx); S.A = (const char*)MIX; S.Bt = (const char*)WO; \
        pg8::EpiOutProj E{MO, SSQAT, x}; \
        pg8::gemm_phase<pg8::EpiOutProj, pg8::DenseSched, true, true>(lds, S, E); } while (0)
#define P3X_BODY(first_) do { const int lane_ = opaque_tid() & 63; _Pragma("unroll 1") for (int s_ = 0; s_ < 4; ++s_) { \
        const XItem xd = xitem_decode((first_) + (bx >> 1) * 32 + wid * 4 + s_, args.in[I_WE1], (unsigned char*)W1, lane_); f32x4 xw[16]; xitem_load(xd, xw); xitem_store(xd, xw); } } while (0)
    if (IN(3)) {
        if (bx & 1) P3X_BODY(0);
        P3_BODY();
        if (!(bx & 1)) P3X_BODY(4096);
#if PROBE_REP == 3
        GRID_BAR(); P3_BODY();
#endif
        if (BOTH(3)) GRID_BAR();
    }

    if (IN(4)) {
#if PROBE_REP == 4
        p4_router(lds, x, MO, HB, GATES, (int*)ACT, ctl + CW_ECNT + 1024, args.in[I_GMOE], args.in[I_WR], args.in[I_BR], G, bx, args.in[I_WE1], (unsigned char*)W1);
        GRID_BAR();
#endif
        p4_router(lds, x, MO, HB, GATES, LIST, ECNT, args.in[I_GMOE], args.in[I_WR], args.in[I_BR], G, bx, args.in[I_WE1], (unsigned char*)W1);
        if (BOTH(4)) GRID_BAR();
    }

    LAS int* ptl = (LAS int*)(lds + LDS_PT); LAS int* cntl = (LAS int*)(lds + LDS_PT + 256);
    if (IN(5) || IN(6)) {
        if (tid < 64) { const int e = lane & 31; const int c = (int)__hip_atomic_load(ECNT + e, __ATOMIC_RELAXED, __HIP_MEMORY_SCOPE_AGENT); const int nt_e = (c + 255) >> 8;
            int incl = nt_e;
#pragma unroll
            for (int o = 1; o < 32; o <<= 1) { const int up = __shfl_up(incl, o, 32); if (e >= o) incl += up; }
            if (tid < 32) { cntl[e] = c; ptl[e + 1] = incl; if (e == 0) ptl[0] = 0; } }
        __syncthreads();
    }
    if (IN(5)) for (int rep = 0; rep < NREP(5); ++rep) {
        if (rep) GRID_BAR();
        pg8::GroupSched<true> S; S.o.init(ptl[32], 2048 / 256, G, bx); S.pt = ptl; S.cnt = cntl; S.A = (const char*)HB; S.Bt = (const char*)W1; S.nrows = 2048; S.list = LIST;
        pg8::EpiSwiglu E{ACT, args.in[I_BE1]};
        pg8::gemm_phase<pg8::EpiSwiglu, pg8::GroupSched<true>, true, true, true>(lds, S, E);
        {
            constexpr int I_2 = 8 * 32;
            for (;;) {
                __syncthreads();
                if (tid == 0) MISC[24] = __hip_atomic_fetch_add(ctl + CW_W2Q, 16u, __ATOMIC_RELAXED, __HIP_MEMORY_SCOPE_AGENT);
                __syncthreads();
                const int base = (int)MISC[24];
                if (base >= NE * I_2) break;
#pragma unroll 1
                for (int sub = 0; sub < 2; ++sub) { const int it = base + 2 * wid + sub;
                const int e = it / I_2, q = it % I_2, kb = q / 32, nb = q % 32;
                transpose_item<128, true>(args.in[I_WE2] + (size_t)e * DE * D, DE, D, (unsigned char*)W2 + (size_t)e * D * DE, 32 * nb, 128 * kb, 32 * nb, pg8::WSCALE, lane); }
            }
        }
        if (BOTH(5)) GRID_BAR();
    }
    if (IN(6)) for (int rep = 0; rep < NREP(6); ++rep) {
        if (rep) GRID_BAR();
        pg8::GroupSched<false> S; S.o.init(ptl[32], D / 256, G, bx); S.pt = ptl; S.cnt = cntl; S.A = (const char*)ACT; S.Bt = (const char*)W2; S.nrows = 1024; S.list = LIST;
        pg8::EpiDown E{Y, args.in[I_BE2], LIST, cntl};
        pg8::gemm_phase<pg8::EpiDown, pg8::GroupSched<false>, true, true, true, true>(lds, S, E);
        if (BOTH(6)) GRID_BAR();
    }
    if (IN(7)) for (int rep7 = 0; rep7 < NREP(7); ++rep7) {
        float* const dst7 = (NREP(7) == 2 && rep7 == 0) ? (float*)ACT : out;
        const int lane = opaque_tid() & 63;
#pragma unroll 2
        for (int m = gw; m < T; m += NGW) {
            const f32x4 gt = *(const f32x4*)(GATES + (size_t)m * 4);
            const u32x2* mr = (const u32x2*)(MO + (size_t)m * D) + lane; f32x4 v[4];
#pragma unroll
            for (int j = 0; j < 4; ++j) { const u32x2 mv = __builtin_nontemporal_load(mr + 64 * j);
                v[j] = (f32x4){__builtin_bit_cast(float, mv.x << 16), __builtin_bit_cast(float, mv.x & 0xffff0000u), __builtin_bit_cast(float, mv.y << 16), __builtin_bit_cast(float, mv.y & 0xffff0000u)}; }
#pragma unroll
            for (int k = 0; k < 4; ++k) { const unsigned* yr = (const unsigned*)(Y + ((size_t)m * 4 + k) * D) + lane; const float gk = gt[k];
#pragma unroll
                for (int j = 0; j < 4; ++j) { const unsigned w = __builtin_nontemporal_load(yr + 64 * j);
                    const f32x2 lo = __builtin_amdgcn_cvt_pk_f32_fp8((int)w, false), hi2 = __builtin_amdgcn_cvt_pk_f32_fp8((int)w, true);
                    v[j][0] += gk * lo[0]; v[j][1] += gk * lo[1]; v[j][2] += gk * hi2[0]; v[j][3] += gk * hi2[1]; } }
            f32x4* orow = (f32x4*)(dst7 + (size_t)m * D) + lane;
#pragma unroll
            for (int j = 0; j < 4; ++j) __builtin_nontemporal_store(v[j], orow + 64 * j);
        }
    }
#undef IN
#undef BOTH
}

extern "C" void kernel_launch(void* const* d_in, const int* in_sizes, int n_in, void* d_out, int out_size, void* d_ws, size_t ws_size, hipStream_t stream) {
    static int grid = 0;
    if (grid == 0) {
        if (n_in != 19 || in_sizes[0] != T * D || out_size != T * D || ws_size < WS_END) { fprintf(stderr, "kernel_launch: unexpected shapes (n_in %d, in0 %d, out %d, ws %zu)\n", n_in, n_in > 0 ? in_sizes[0] : -1, out_size, ws_size); grid = -1; return; }
        int dev = 0, cus = 0, per_cu = 0;
        if (hipGetDevice(&dev) != hipSuccess || hipDeviceGetAttribute(&cus, hipDeviceAttributeMultiprocessorCount, dev) != hipSuccess) { grid = -1; return; }
        if (hipFuncSetAttribute((const void*)fwd_kernel, hipFuncAttributeMaxDynamicSharedMemorySize, LDS_BYTES) != hipSuccess) { fprintf(stderr, "kernel_launch: hipFuncSetAttribute failed\n"); grid = -1; return; }
        if (hipOccupancyMaxActiveBlocksPerMultiprocessor(&per_cu, (const void*)fwd_kernel, 512, LDS_BYTES) != hipSuccess || per_cu < 1) fprintf(stderr, "kernel_launch: occupancy query reports %d\n", per_cu);
        (void)hipGetLastError();
        grid = cus;
        if (grid != 256) { fprintf(stderr, "kernel_launch: built for a 256-CU device (work maps assume 256 workgroups), found %d CUs; nothing launched\n", cus); grid = -1; return; }
    }
    if (grid < 0) return;
    (void)hipMemsetAsync((char*)d_ws + WS_CTL, 0, CTL_ZERO_BYTES, stream);
    Args a{};
    for (int i = 0; i < 19; ++i) a.in[i] = (const float*)d_in[i];
    a.out = (float*)d_out; a.ws = (unsigned char*)d_ws;
#if MK_SPLIT
    for (int p = 0; p < 8; ++p) { a.ph_lo = p; a.ph_hi = p + 1; hipLaunchKernelGGL(fwd_kernel, dim3(grid), dim3(512), LDS_BYTES, stream, a); }
#else
    a.ph_lo = 0; a.ph_hi = 8;
    hipLaunchKernelGGL(fwd_kernel, dim3(grid), dim3(512), LDS_BYTES, stream, a);
#endif
}
```

```cpp
#include <hip/hip_runtime.h>
#include <cstdio>
#include <cstdint>

#define GAS __attribute__((address_space(1)))
#define LAS __attribute__((address_space(3)))
typedef unsigned short bf16_t;
typedef short bf16x8 __attribute__((ext_vector_type(8)));
typedef short s16x4 __attribute__((ext_vector_type(4)));
typedef float f32x2 __attribute__((ext_vector_type(2)));
typedef float f32x4 __attribute__((ext_vector_type(4)));
typedef float f32x16 __attribute__((ext_vector_type(16)));
typedef unsigned u32x2 __attribute__((ext_vector_type(2)));
typedef unsigned u32x4 __attribute__((ext_vector_type(4)));
typedef int i32x4 __attribute__((ext_vector_type(4)));
typedef int i32x8 __attribute__((ext_vector_type(8)));

#ifndef PROBE_REP
#define PROBE_REP -1
#endif
#define NREP(k) ((k) == PROBE_REP ? 2 : 1)
#ifndef MK_SPLIT
#define MK_SPLIT 0
#endif

constexpr int NBATCH = 8, SEQ = 4096, D = 1024, T = NBATCH * SEQ;
constexpr int NPROJ = 2560, NE = 32, TOPK = 4, DE = 1024;
constexpr int NA = T * TOPK;
constexpr int LISTCAP = T;
constexpr float EPS = 1e-6f;
constexpr float LOG2E = 1.4426950408889634f;
constexpr float C2 = 0.125f * LOG2E;

constexpr size_t MiB = 1u << 20;
constexpr size_t WS_CTL = 0, CTL_ZERO_BYTES = 128 * 1024;
constexpr size_t WS_WIN = 1 * MiB;
constexpr size_t WS_WO = 6 * MiB;
constexpr size_t WS_W1 = 8 * MiB;
constexpr size_t WS_W2 = 136 * MiB;
constexpr size_t WS_HB = 200 * MiB;
constexpr size_t WS_SSQGV = 264 * MiB;
constexpr size_t WS_SSQAT = 265 * MiB;
constexpr size_t WS_GATES = 266 * MiB;
constexpr size_t WS_MH = 266 * MiB + 768 * 1024;
constexpr size_t WS_WSB = 266 * MiB + 832 * 1024;
constexpr size_t WS_LIST = 267 * MiB;
constexpr size_t WS_ACT = 272 * MiB;
constexpr size_t WS_Y = 672 * MiB;
constexpr size_t WS_XB = 544 * MiB;
constexpr size_t WS_MO = 608 * MiB;
constexpr size_t WS_Q = 608 * MiB;
constexpr size_t WS_MIX = 768 * MiB;
constexpr size_t WS_END = 800 * MiB;
constexpr size_t QSTRIDE = (size_t)T * 512;
constexpr int CW_BAR = 4096;
constexpr int CW_ECNT = 16384;
constexpr int CW_W2Q = 17408;

constexpr int RING_BYTES = 131072;
constexpr int LDS_BYTES = 163840;
constexpr int LDS_LCNT = LDS_BYTES - 3072;
constexpr int LDS_PT = LDS_BYTES - 2048;
constexpr int LDS_MISC = LDS_BYTES - 1024;

__device__ __forceinline__ unsigned cvt_pk_bf16(float lo, float hi) { unsigned r; asm volatile("v_cvt_pk_bf16_f32 %0, %1, %2" : "=v"(r) : "v"(lo), "v"(hi)); return r; }
__device__ __forceinline__ float bf2f(unsigned short b) { return __builtin_bit_cast(float, (unsigned)b << 16); }
__device__ __forceinline__ float wave_sum(float v) {
#pragma unroll
    for (int o = 1; o < 64; o <<= 1) v += __shfl_xor(v, o);
    return v;
}
__device__ __forceinline__ float wave_max(float v) {
#pragma unroll
    for (int o = 1; o < 64; o <<= 1) v = fmaxf(v, __shfl_xor(v, o));
    return v;
}
__device__ __forceinline__ int opaque_tid() { int t = threadIdx.x; asm volatile("" : "+v"(t)); return t; }
__device__ __forceinline__ void glds16(const void* gsrc, unsigned lds_dst) { unsigned keep;
    asm volatile("s_mov_b32 %0, m0\n\ts_mov_b32 m0, %2\n\ts_nop 0\n\tglobal_load_lds_dwordx4 %1, off\n\ts_mov_b32 m0, %0" : "=&s"(keep) : "v"(gsrc), "s"(lds_dst) : "memory"); }
__device__ __forceinline__ unsigned lds_addr(const LAS void* p) { return (unsigned)(size_t)p; }
#define LDS_WAIT() asm volatile("s_waitcnt lgkmcnt(0)" ::: "memory")
#define VM_WAIT() asm volatile("s_waitcnt vmcnt(0)" ::: "memory")

__device__ __forceinline__ f32x2 gelu_pk(f32x2 v) {
    const f32x2 av = __builtin_elementwise_abs(v), d = av * 0.2316418882f + 1.0f;
    f32x2 t; t.x = __builtin_amdgcn_rcpf(d.x); t.y = __builtin_amdgcn_rcpf(d.y);
    f32x2 q = t * 0.5307027145f + (-0.7265760135f); q = q * t + 0.7107068705f; q = q * t + (-0.142248368f); q = q * t + 0.127414796f; q = q * t;
    const f32x2 s = (v * v) * (-0.72134752044f);
    f32x2 e; e.x = __builtin_amdgcn_exp2f(s.x); e.y = __builtin_amdgcn_exp2f(s.y);
    const f32x2 m = v * (q * e), r = v - m;
    f32x2 o; o.x = v.x < 0.f ? m.x : r.x; o.y = v.y < 0.f ? m.y : r.y; return o;
}
__device__ __forceinline__ f32x4 gelu4(f32x4 v) { f32x2 a = gelu_pk((f32x2){v[0], v[1]}), b = gelu_pk((f32x2){v[2], v[3]}); return (f32x4){a.x, a.y, b.x, b.y}; }

namespace pg8 {
constexpr int BM = 256, BK = 64, HALF = 128, HTB = HALF * BK * 2, NXCD = 8, WGM = 4, KD = 1024;
__host__ __device__ __forceinline__ int lds_byte(int r, int c) { const int st = (r >> 4) * 2 + (c >> 5), rr = r & 15, cc = c & 31, ob = rr * 64 + cc * 2; return st * 1024 + (ob ^ (((ob >> 9) & 1) << 5)); }
__host__ __device__ __forceinline__ void stage_rc(int b, int& R, int& C) { const int st = b / 1024, sb = b % 1024, swz = sb ^ (((sb >> 9) & 1) << 5); R = (st >> 1) * 16 + swz / 64; C = (st & 1) * 32 + (swz % 64) / 2; }
__host__ __device__ __forceinline__ int perm32(int rho) { const int n = rho >> 4, i = rho & 15; return 8 * (i >> 2) + 4 * n + (i & 3); }

struct Unit { int pm, pn, e, mt; };

struct TileOrder {
    int nM, nN, nwg, G, c;
    __device__ __forceinline__ void init(int nM_, int nN_, int G_, int c_) { nM = nM_; nN = nN_; nwg = nM * nN; G = G_; c = c_; }
    __device__ __forceinline__ bool tile(int i, int& pm, int& pn) const {
        const long L = (long)i * G + c; if (L >= nwg) return false;
        int wgid = (int)L; { const int q = nwg / NXCD, r = nwg % NXCD, xcd = wgid % NXCD, off = wgid / NXCD; wgid = (xcd < r ? xcd * (q + 1) : r * (q + 1) + (xcd - r) * q) + off; }
        const int nig = WGM * nN, gid = wgid / nig, fm = gid * WGM, gsz = (nM - fm) < WGM ? (nM - fm) : WGM;
        pm = fm + ((wgid % nig) % gsz); pn = (wgid % nig) / gsz; return true;
    }
};

__device__ __forceinline__ i32x8 cat8(bf16x8 a, bf16x8 b) { const i32x4 x = __builtin_bit_cast(i32x4, a), y = __builtin_bit_cast(i32x4, b); return __builtin_shufflevector(x, y, 0, 1, 2, 3, 4, 5, 6, 7); }
template <class Epi, class Sched, bool ALIGN_EPI, bool SP2, bool FP8 = false, bool COL16 = false>
__device__ __forceinline__ void gemm_phase(LAS unsigned char* lds, const Sched& S, const Epi& E) {
    const int tid = opaque_tid(), wid = __builtin_amdgcn_readfirstlane(tid >> 6), lane = tid & 63, wr = wid >> 2, wc = wid & 3, fr = lane & 15, fq = lane >> 4;
    constexpr int K = FP8 ? KD / 2 : KD  , nt = K / BK;
    int sR[2], sC[2];
    unsigned voffB[2], vA[2][2];
#pragma unroll
    for (int i = 0; i < 2; ++i) {
        sR[i] = 8 * (wid + 8 * i) + (lane >> 3); sC[i] = 8 * ((lane & 7) ^ ((sR[i] >> 1) & 7)); const int rho = sR[i] & 31;
        const int Rb = COL16 ? 64 * (sR[i] >> 5) + 16 * ((rho & 15) >> 2) + 4 * (rho >> 4) + (rho & 3) : 64 * (sR[i] >> 5) + perm32(rho);
        voffB[i] = (unsigned)(Rb * K + sC[i]) * 2u;
        vA[0][i] = (unsigned)(sR[i] * K + sC[i]) * 2u; vA[1][i] = (unsigned)((sR[i] + HALF) * K + sC[i]) * 2u; }
    constexpr size_t kstep = (size_t)(BK * 2);
    constexpr size_t hstepB = (size_t)(COL16 ? 8 : 32) * K * 2;
    const unsigned ldsw = (unsigned)wid * 1024u;
    const int aoff0 = (wr * 64 + fr) * 128 + 16 * (fq ^ (fr >> 1)), aoff1 = (wr * 64 + fr) * 128 + 16 * ((4 + fq) ^ (fr >> 1));
    const int boff0 = (wc * 32 + fr) * 128 + 16 * (fq ^ (fr >> 1)), boff1 = (wc * 32 + fr) * 128 + 16 * ((4 + fq) ^ (fr >> 1));
#define PG8_SA(b, h) (((b) * 2 + (h)) * HTB)
#define PG8_SB(b, h) ((4 + (b) * 2 + (h)) * HTB)
#define PG8_STAGE(bufoff, gbase, v0, v1) do { \
        __builtin_amdgcn_global_load_lds((const unsigned*)((const char*)(gbase) + (v0)), (LAS unsigned*)(lds + (bufoff) + ldsw), 16, 0, 0); \
        __builtin_amdgcn_global_load_lds((const unsigned*)((const char*)(gbase) + (v1)), (LAS unsigned*)(lds + (bufoff) + ldsw + 8192), 16, 0, 0); } while (0)
#define PG8_STAGE_B(bufoff, gbase) PG8_STAGE(bufoff, gbase, voffB[0], voffB[1])
#define PG8_STAGE_A(bufoff, gbase, V, h) PG8_STAGE(bufoff, gbase, V[h][0], V[h][1])
#define PG8_LDA(dst, b, h) do { _Pragma("unroll") for (int m = 0; m < 4; ++m) { \
        if constexpr (FP8) { const i32x4 lo_ = *(const LAS i32x4*)(lds + PG8_SA(b, h) + aoff0 + m * 2048), hi_ = *(const LAS i32x4*)(lds + PG8_SA(b, h) + aoff1 + m * 2048); dst##8[m] = __builtin_shufflevector(lo_, hi_, 0, 1, 2, 3, 4, 5, 6, 7); } \
        else { dst[m][0] = *(const LAS bf16x8*)(lds + PG8_SA(b, h) + aoff0 + m * 2048); dst[m][1] = *(const LAS bf16x8*)(lds + PG8_SA(b, h) + aoff1 + m * 2048); } } } while (0)
#define PG8_LDB(dst, b, h) do { _Pragma("unroll") for (int n = 0; n < 2; ++n) { \
        if constexpr (FP8) { const i32x4 lo_ = *(const LAS i32x4*)(lds + PG8_SB(b, h) + boff0 + n * 2048), hi_ = *(const LAS i32x4*)(lds + PG8_SB(b, h) + boff1 + n * 2048); dst##8[n] = __builtin_shufflevector(lo_, hi_, 0, 1, 2, 3, 4, 5, 6, 7); } \
        else { dst[n][0] = *(const LAS bf16x8*)(lds + PG8_SB(b, h) + boff0 + n * 2048); dst[n][1] = *(const LAS bf16x8*)(lds + PG8_SB(b, h) + boff1 + n * 2048); } } } while (0)
#define PG8_MMA(ai, bj, At, Bt) do { __builtin_amdgcn_s_setprio(1); _Pragma("unroll") for (int m = 0; m < 4; ++m) _Pragma("unroll") for (int n = 0; n < 2; ++n) { \
        if constexpr (FP8) asm volatile("v_mfma_scale_f32_16x16x128_f8f6f4 %0, %1, %2, %0, %3, %3 op_sel_hi:[0,0,0]" : "+v"(acc[ai][bj][m][n]) : "v"(Bt##8[n]), "v"(At##8[m]), "v"(scl)); \
        else { _Pragma("unroll") for (int k = 0; k < 2; ++k) acc[ai][bj][m][n] = __builtin_amdgcn_mfma_f32_16x16x32_bf16(Bt[n][k], At[m][k], acc[ai][bj][m][n], 0, 0, 0); } } \
        __builtin_amdgcn_s_setprio(0); } while (0)
#define PG8_WAIT_V(n) asm volatile("s_waitcnt vmcnt(" #n ")" ::: "memory")
#define PG8_WAIT_L(n) asm volatile("s_waitcnt lgkmcnt(" #n ")" ::: "memory")
#define PG8_BAR __builtin_amdgcn_s_barrier()
#define PG8_SCHED __builtin_amdgcn_sched_barrier(0)
    Unit cur, nxt; int ui = 0;
    if (!S.next(0, cur)) return;
    LAS u32x4* const gslot = (LAS u32x4*)(lds + 131072) + tid;
    LAS unsigned char* const metab = lds + 139264;
    if constexpr (Sched::GATHER) { S.gather(cur, sR, sC, vA); Unit u1; if (S.next(1, u1)) { unsigned t_[2][2]; S.gather(u1, sR, sC, t_); *gslot = (u32x4){t_[0][0], t_[0][1], t_[1][0], t_[1][1]}; } }
    if constexpr (Epi::META) E.meta_finish(E.meta_issue(cur, tid), metab, tid);
    f32x4 acc[2][2][4][2];
#pragma unroll
    for (int a = 0; a < 2; ++a)
#pragma unroll
        for (int b = 0; b < 2; ++b)
#pragma unroll
            for (int m = 0; m < 4; ++m)
#pragma unroll
                for (int n = 0; n < 2; ++n) acc[a][b][m][n] = (f32x4){0.f, 0.f, 0.f, 0.f};
    bf16x8 At[4][2], B0[2][2], B1[2][2]; i32x8 At8[4], B08[2], B18[2];
    unsigned scl = 0x7F7F7F7Fu; asm volatile("" : "+v"(scl));
    const char* cA = S.a_ptr(cur); const char* cB = S.b_ptr(cur);
    if constexpr (SP2) {
        PG8_STAGE_B(PG8_SB(0, 0), cB); PG8_STAGE_B(PG8_SB(0, 1), cB + hstepB); PG8_STAGE_A(PG8_SA(0, 0), cA, vA, 0); PG8_STAGE_A(PG8_SA(0, 1), cA, vA, 1);
        if (wr == 1) PG8_BAR;
        PG8_WAIT_V(2); PG8_BAR;
        PG8_STAGE_B(PG8_SB(1, 0), cB + kstep); PG8_STAGE_A(PG8_SA(1, 0), cA + kstep, vA, 0); PG8_STAGE_B(PG8_SB(1, 1), cB + hstepB + kstep);
        PG8_WAIT_V(6); PG8_BAR;
    } else {
        PG8_STAGE_B(PG8_SB(0, 0), cB); PG8_STAGE_A(PG8_SA(0, 0), cA, vA, 0); PG8_STAGE_B(PG8_SB(0, 1), cB + hstepB); PG8_STAGE_A(PG8_SA(0, 1), cA, vA, 1);
        if (wr == 1) PG8_BAR;
        PG8_WAIT_V(4); PG8_BAR;
        PG8_STAGE_B(PG8_SB(1, 0), cB + kstep); PG8_STAGE_A(PG8_SA(1, 0), cA + kstep, vA, 0); PG8_STAGE_B(PG8_SB(1, 1), cB + hstepB + kstep);
        PG8_WAIT_V(6); PG8_BAR;
    }
    for (;;) {
        const bool has_next = S.next(ui + 1, nxt);
        const char* nA = has_next ? S.a_ptr(nxt) : cA; const char* nB = has_next ? S.b_ptr(nxt) : cB;
        unsigned w2[2][2] = {{vA[0][0], vA[0][1]}, {vA[1][0], vA[1][1]}};
        for (int t = 0; t < nt; t += 2) {
            const bool last = (t == nt - 2);
            if constexpr (Epi::HAS_MID) { if (t == nt / 2) E.mid(acc, cur, wr, wc, fr, fq); }
            const char* a1 = cA + (size_t)(t + 1) * kstep;
            const char* a2 = last ? nA : cA + (size_t)(t + 2) * kstep; const char* b2 = last ? nB : cB + (size_t)(t + 2) * kstep;
            const char* a3 = a2 + kstep; const char* b3 = b2 + kstep;
            if constexpr (Sched::GATHER) { if (last && has_next) { const u32x4 r_ = *gslot; w2[0][0] = r_[0]; w2[0][1] = r_[1]; w2[1][0] = r_[2]; w2[1][1] = r_[3]; } }
            if constexpr (SP2) {
            PG8_LDB(B0, 0, 0); PG8_LDB(B1, 0, 1); PG8_SCHED; PG8_LDA(At, 0, 0); PG8_STAGE_A(PG8_SA(1, 1), a1, vA, 1);
            PG8_WAIT_V(8); PG8_WAIT_L(0); PG8_BAR; PG8_MMA(0, 0, At, B0); PG8_MMA(0, 1, At, B1); PG8_BAR; PG8_SCHED;
            PG8_LDA(At, 0, 1); PG8_STAGE_B(PG8_SB(0, 0), b2); PG8_STAGE_B(PG8_SB(0, 1), b2 + hstepB); PG8_STAGE_A(PG8_SA(0, 0), a2, w2, 0);
            PG8_WAIT_V(8); PG8_WAIT_L(0); PG8_BAR; PG8_MMA(1, 0, At, B0); PG8_MMA(1, 1, At, B1); PG8_BAR; PG8_SCHED;
            PG8_LDB(B0, 1, 0); PG8_LDB(B1, 1, 1); PG8_SCHED; PG8_LDA(At, 1, 0); PG8_STAGE_A(PG8_SA(0, 1), a2, w2, 1);
            PG8_WAIT_V(8); PG8_WAIT_L(0); PG8_BAR; PG8_MMA(0, 0, At, B0); PG8_MMA(0, 1, At, B1); PG8_BAR; PG8_SCHED;
            PG8_LDA(At, 1, 1); PG8_STAGE_B(PG8_SB(1, 0), b3); PG8_STAGE_B(PG8_SB(1, 1), b3 + hstepB); PG8_STAGE_A(PG8_SA(1, 0), a3, w2, 0);
            PG8_WAIT_V(8); PG8_WAIT_L(0); PG8_BAR; PG8_MMA(1, 0, At, B0); PG8_MMA(1, 1, At, B1); PG8_BAR; PG8_SCHED;
            } else {
            PG8_LDB(B0, 0, 0); PG8_SCHED; PG8_LDA(At, 0, 0); PG8_STAGE_A(PG8_SA(1, 1), a1, vA, 1);
            PG8_WAIT_L(8); PG8_BAR; PG8_WAIT_L(0); PG8_MMA(0, 0, At, B0); PG8_BAR; PG8_SCHED;
            PG8_LDB(B1, 0, 1); PG8_STAGE_B(PG8_SB(0, 0), b2);
            PG8_BAR; PG8_WAIT_L(0); PG8_MMA(0, 1, At, B1); PG8_BAR;
            PG8_LDA(At, 0, 1); PG8_STAGE_A(PG8_SA(0, 0), a2, w2, 0);
            PG8_BAR; PG8_WAIT_L(0); PG8_MMA(1, 0, At, B0); PG8_BAR; PG8_SCHED;
            PG8_STAGE_B(PG8_SB(0, 1), b2 + hstepB);
            PG8_WAIT_V(6); PG8_BAR; PG8_MMA(1, 1, At, B1); PG8_BAR;
            PG8_LDB(B0, 1, 0); PG8_SCHED; PG8_LDA(At, 1, 0); PG8_STAGE_A(PG8_SA(0, 1), a2, w2, 1);
            PG8_WAIT_L(8); PG8_BAR; PG8_WAIT_L(0); PG8_MMA(0, 0, At, B0); PG8_BAR; PG8_SCHED;
            PG8_LDB(B1, 1, 1); PG8_STAGE_B(PG8_SB(1, 0), b3);
            PG8_BAR; PG8_WAIT_L(0); PG8_MMA(0, 1, At, B1); PG8_BAR;
            PG8_LDA(At, 1, 1); PG8_STAGE_A(PG8_SA(1, 0), a3, w2, 0);
            PG8_BAR; PG8_WAIT_L(0); PG8_MMA(1, 0, At, B0); PG8_BAR; PG8_SCHED;
            PG8_STAGE_B(PG8_SB(1, 1), b3 + hstepB);
            PG8_WAIT_V(6); PG8_BAR; PG8_MMA(1, 1, At, B1); PG8_BAR;
            }
        }
        if constexpr (ALIGN_EPI) { if (wr == 0) PG8_BAR; }
        if constexpr (FP8) asm volatile("s_nop 15\n\ts_nop 15" ::: "memory");
        {
            Unit n2; bool h2 = false; int raw_[2][2] = {{0, 0}, {0, 0}}; unsigned mreg_ = 0u;
            if constexpr (Sched::GATHER) { h2 = S.next(ui + 2, n2); if (h2) S.gather_issue(n2, sR, raw_); }
            if constexpr (Epi::META) { if (has_next) mreg_ = E.meta_issue(nxt, tid); }
            if constexpr (Epi::META) E.run(acc, cur, wr, wc, fr, fq, metab + (ui & 1) * 2048); else E(acc, cur, wr, wc, fr, fq);
            if constexpr (Sched::GATHER) { if (h2) { unsigned t_[2][2]; S.gather_finish(raw_, sC, t_); *gslot = (u32x4){t_[0][0], t_[0][1], t_[1][0], t_[1][1]}; } }
            if constexpr (Epi::META) { if (has_next) E.meta_finish(mreg_, metab + ((ui + 1) & 1) * 2048, tid); }
        }
        if (!has_next) break;
#pragma unroll
        for (int a = 0; a < 2; ++a)
#pragma unroll
            for (int b = 0; b < 2; ++b)
#pragma unroll
                for (int m = 0; m < 4; ++m)
#pragma unroll
                    for (int n = 0; n < 2; ++n) acc[a][b][m][n] = (f32x4){0.f, 0.f, 0.f, 0.f};
        if constexpr (FP8) asm volatile("s_nop 7" ::: "memory");
        cur = nxt; cA = nA; cB = nB; ++ui;
        if constexpr (Sched::GATHER) {
#pragma unroll
            for (int h = 0; h < 2; ++h)
#pragma unroll
                for (int i = 0; i < 2; ++i) vA[h][i] = w2[h][i];
        }
        if constexpr (ALIGN_EPI) { if (wr == 1) PG8_BAR; }
    }
    PG8_WAIT_V(0);
    if constexpr (!ALIGN_EPI) { if (wr == 0) PG8_BAR; }
    PG8_BAR;
#undef PG8_SA
#undef PG8_SB
#undef PG8_STAGE
#undef PG8_STAGE_A
#undef PG8_STAGE_B
#undef PG8_LDA
#undef PG8_LDB
#undef PG8_MMA
#undef PG8_WAIT_V
#undef PG8_WAIT_L
#undef PG8_BAR
#undef PG8_SCHED
}

struct DenseSched {
    static constexpr bool GATHER = false; static constexpr int KB = KD * 2;
    TileOrder o; const char* A; const char* Bt;
    __device__ __forceinline__ bool next(int i, Unit& u) const { if (!o.tile(i, u.pm, u.pn)) return false; u.e = 0; u.mt = u.pm; return true; }
    __device__ __forceinline__ const char* a_ptr(const Unit& u) const { return A + (size_t)u.pm * ((size_t)BM * KB); }
    __device__ __forceinline__ const char* b_ptr(const Unit& u) const { return Bt + (size_t)u.pn * ((size_t)BM * KB); }
    __device__ __forceinline__ void gather(const Unit&, const int (&)[2], const int (&)[2], unsigned (&)[2][2]) const {}
    __device__ __forceinline__ void gather_issue(const Unit&, const int (&)[2], int (&)[2][2]) const {}
    __device__ __forceinline__ void gather_finish(const int (&)[2][2], const int (&)[2], unsigned (&)[2][2]) const {}
};
template <bool GATHER_>
struct GroupSched {
    static constexpr bool GATHER = GATHER_; static constexpr int KB = KD;
    TileOrder o; const LAS int* pt; const LAS int* cnt; const char* A; const char* Bt; int nrows; const int* list;
    __device__ __forceinline__ bool next(int i, Unit& u) const {
        if (!o.tile(i, u.pm, u.pn)) return false;
        const int lane = threadIdx.x & 63;
        const int pe = pt[(lane & 31) + 1];
        const unsigned long long bal = __ballot(u.pm >= pe) & 0xffffffffull;
        const int e = __builtin_amdgcn_readfirstlane(__popcll(bal)); u.e = e > 31 ? 31 : e; u.mt = u.pm - __builtin_amdgcn_readfirstlane(pt[u.e]); return true;
    }
    __device__ __forceinline__ const char* a_ptr(const Unit& u) const { return GATHER ? A : A + (size_t)u.pm * ((size_t)BM * KB); }
    __device__ __forceinline__ const char* b_ptr(const Unit& u) const { return Bt + ((size_t)u.e * nrows + (size_t)u.pn * BM) * ((size_t)KB); }
    __device__ __forceinline__ void gather_issue(const Unit& u, const int (&sR)[2], int (&raw)[2][2]) const {
        const int n = cnt[u.e];
#pragma unroll
        for (int h = 0; h < 2; ++h)
#pragma unroll
            for (int i = 0; i < 2; ++i) { const int idx = u.mt * BM + h * HALF + sR[i]; raw[h][i] = list[u.e * LISTCAP + (idx < n ? idx : n - 1)]; }
    }
    __device__ __forceinline__ void gather_finish(const int (&raw)[2][2], const int (&sC)[2], unsigned (&v)[2][2]) const {
#pragma unroll
        for (int h = 0; h < 2; ++h)
#pragma unroll
            for (int i = 0; i < 2; ++i) v[h][i] = (unsigned)((raw[h][i] >> 2) * KB + sC[i] * 2);
    }
    __device__ __forceinline__ void gather(const Unit& u, const int (&sR)[2], const int (&sC)[2], unsigned (&v)[2][2]) const { int raw[2][2]; gather_issue(u, sR, raw); gather_finish(raw, sC, v); }
};

__device__ __forceinline__ u32x4 pack8(f32x4 a, f32x4 b) { u32x4 w; w.x = cvt_pk_bf16(a[0], a[1]); w.y = cvt_pk_bf16(a[2], a[3]); w.z = cvt_pk_bf16(b[0], b[1]); w.w = cvt_pk_bf16(b[2], b[3]); return w; }

__device__ __forceinline__ float clamp448(float v) { return fminf(fmaxf(v, -448.0f), 448.0f); }
__device__ __forceinline__ unsigned pack4_fp8(f32x4 a) { int p = 0; p = __builtin_amdgcn_cvt_pk_fp8_f32(clamp448(a[0]), clamp448(a[1]), p, false); p = __builtin_amdgcn_cvt_pk_fp8_f32(clamp448(a[2]), clamp448(a[3]), p, true); return (unsigned)p; }
__device__ __forceinline__ unsigned pack4_fp8_nc(f32x4 a) { int p = 0; p = __builtin_amdgcn_cvt_pk_fp8_f32(a[0], a[1], p, false); p = __builtin_amdgcn_cvt_pk_fp8_f32(a[2], a[3], p, true); return (unsigned)p; }
constexpr float WSCALE = 32.0f, WINV = 1.0f / 32.0f;

struct EpiInProj {
    static constexpr bool HAS_MID = false, META = false;
    bf16_t* obase; const float* qg; const float* kg; float* ssq_gv;
    __device__ __forceinline__ void mid(f32x4 (&)[2][2][4][2], const Unit&, int, int, int, int) const {}
    __device__ __forceinline__ void operator()(const f32x4 (&acc)[2][2][4][2], const Unit& u, int wr, int wc, int fr, int fq) const {
        const int kind = u.pn >> 1;
        bf16_t* O = obase + (size_t)kind * QSTRIDE;
        const int col0 = (u.pn & 1) * 256 + wc * 64 + 8 * fq;
        const int row0 = u.pm * BM + wr * 64 + fr;
        if (kind <= 1) {
            const float* g = kind == 0 ? qg : kg; const float sc = kind == 0 ? C2 : 1.0f;
            f32x4 gv[2][2];
#pragma unroll
            for (int bj = 0; bj < 2; ++bj)
#pragma unroll
                for (int n = 0; n < 2; ++n) gv[bj][n] = *(const f32x4*)(g + 32 * bj + 8 * fq + 4 * n) * sc;
#pragma unroll
            for (int ai = 0; ai < 2; ++ai)
#pragma unroll
                for (int m = 0; m < 4; ++m) {
                    float ss = 0.f;
#pragma unroll
                    for (int bj = 0; bj < 2; ++bj)
#pragma unroll
                        for (int n = 0; n < 2; ++n) { const f32x4 x = acc[ai][bj][m][n]; ss += (x[0] * x[0] + x[1] * x[1]) + (x[2] * x[2] + x[3] * x[3]); }
                    ss += __shfl_xor(ss, 16); ss += __shfl_xor(ss, 32);
                    const float rs = __builtin_amdgcn_rsqf(ss * (1.0f / 64.0f) + EPS);
                    bf16_t* rowp = O + (size_t)(row0 + ai * HALF + m * 16) * 512 + col0;
#pragma unroll
                    for (int bj = 0; bj < 2; ++bj) *(u32x4*)(rowp + 32 * bj) = pack8(acc[ai][bj][m][0] * rs * gv[bj][0], acc[ai][bj][m][1] * rs * gv[bj][1]);
                }
        } else if (kind == 2) {
#pragma unroll
            for (int ai = 0; ai < 2; ++ai)
#pragma unroll
                for (int m = 0; m < 4; ++m) { bf16_t* rowp = O + (size_t)(row0 + ai * HALF + m * 16) * 512 + col0;
#pragma unroll
                    for (int bj = 0; bj < 2; ++bj) *(u32x4*)(rowp + 32 * bj) = pack8(acc[ai][bj][m][0], acc[ai][bj][m][1]); }
        } else if (kind == 3) {
#pragma unroll
            for (int ai = 0; ai < 2; ++ai)
#pragma unroll
                for (int m = 0; m < 4; ++m) { bf16_t* rowp = O + (size_t)(row0 + ai * HALF + m * 16) * 512 + col0;
#pragma unroll
                    for (int bj = 0; bj < 2; ++bj) *(u32x4*)(rowp + 32 * bj) = pack8(gelu4(acc[ai][bj][m][0]), gelu4(acc[ai][bj][m][1])); }
        } else {
#pragma unroll
            for (int ai = 0; ai < 2; ++ai)
#pragma unroll
                for (int m = 0; m < 4; ++m) { const int row = row0 + ai * HALF + m * 16; bf16_t* rowp = O + (size_t)row * 512 + col0; float ss = 0.f;
#pragma unroll
                    for (int bj = 0; bj < 2; ++bj) { const f32x4 a = gelu4(acc[ai][bj][m][0]), b = gelu4(acc[ai][bj][m][1]);
                        ss += (a[0] * a[0] + a[1] * a[1]) + (a[2] * a[2] + a[3] * a[3]) + (b[0] * b[0] + b[1] * b[1]) + (b[2] * b[2] + b[3] * b[3]);
                        *(u32x4*)(rowp + 32 * bj) = pack8(a, b); }
                    ss += __shfl_xor(ss, 16); ss += __shfl_xor(ss, 32);
                    if (fq == 0) ssq_gv[(size_t)row * 8 + (u.pn & 1) * 4 + wc] = ss; }
        }
    }
};

struct EpiOutProj {
    static constexpr bool HAS_MID = true, META = false;
    bf16_t* mo; const float* ssq_att; const float* x;
    __device__ __forceinline__ void mid(f32x4 (&acc)[2][2][4][2], const Unit& u, int wr, int wc, int fr, int fq) const {
#pragma unroll
        for (int ai = 0; ai < 2; ++ai)
#pragma unroll
            for (int m = 0; m < 4; ++m) { const int row = u.pm * BM + ai * HALF + wr * 64 + m * 16 + fr;
                const f32x4 a = *(const f32x4*)(ssq_att + (size_t)row * 8), b = *(const f32x4*)(ssq_att + (size_t)row * 8 + 4);
                const float s = ((a[0] + a[1]) + (a[2] + a[3])) + ((b[0] + b[1]) + (b[2] + b[3]));
                const float rs = __builtin_amdgcn_rsqf(s * (1.0f / 512.0f) + EPS);
#pragma unroll
                for (int bj = 0; bj < 2; ++bj)
#pragma unroll
                    for (int n = 0; n < 2; ++n) acc[ai][bj][m][n] *= rs; }
    }
    __device__ __forceinline__ void operator()(const f32x4 (&acc)[2][2][4][2], const Unit& u, int wr, int wc, int fr, int fq) const {
        f32x4 xr[4][2][2];
#define OP_XLOAD(c) do { const float* xp_ = x + (size_t)(u.pm * BM + ((c) >> 2) * HALF + wr * 64 + ((c) & 3) * 16 + fr) * D + u.pn * BM + wc * 64 + 8 * fq; \
            _Pragma("unroll") for (int bj = 0; bj < 2; ++bj) { xr[(c) & 3][bj][0] = __builtin_nontemporal_load((const f32x4*)(xp_ + 32 * bj)); xr[(c) & 3][bj][1] = __builtin_nontemporal_load((const f32x4*)(xp_ + 32 * bj + 4)); } } while (0)
        OP_XLOAD(0); OP_XLOAD(1); OP_XLOAD(2); OP_XLOAD(3);
#pragma unroll
        for (int c = 0; c < 8; ++c) { const int ai = c >> 2, m = c & 3;
            bf16_t* rowp = mo + (size_t)(u.pm * BM + ai * HALF + wr * 64 + m * 16 + fr) * D + u.pn * BM + wc * 64 + 8 * fq;
#pragma unroll
            for (int bj = 0; bj < 2; ++bj) *(u32x4*)(rowp + 32 * bj) = pack8(acc[ai][bj][m][0] + xr[c & 3][bj][0], acc[ai][bj][m][1] + xr[c & 3][bj][1]);
            if (c + 4 < 8) { asm volatile("" ::: "memory"); OP_XLOAD(c + 4); }
        }
#undef OP_XLOAD
    }
};

struct EpiSwiglu {
    static constexpr bool HAS_MID = false, META = true;
    bf16_t* act; const float* b_in;
    __device__ __forceinline__ void mid(f32x4 (&)[2][2][4][2], const Unit&, int, int, int, int) const {}
    __device__ __forceinline__ unsigned meta_issue(const Unit& u, int tid) const {
        const int t = tid & 255; return __builtin_bit_cast(unsigned, b_in[(size_t)u.e * 2048 + (t >> 7) * 1024 + u.pn * 128 + (t & 127)] + (float)(t >> 7));
    }
    __device__ __forceinline__ void meta_finish(unsigned bits, LAS unsigned char* buf, int tid) const { if (tid < 256) ((LAS unsigned*)buf)[tid] = bits; }
    __device__ __forceinline__ void run(const f32x4 (&acc)[2][2][4][2], const Unit& u, int wr, int wc, int fr, int fq, const LAS unsigned char* buf) const {
        const int cl = wc * 32 + 8 * fq, col = u.pn * 128 + cl;
        f32x4 bg[2], bl[2];
#pragma unroll
        for (int n = 0; n < 2; ++n) { bg[n] = *(const LAS f32x4*)(buf + (cl + 4 * n) * 4); bl[n] = *(const LAS f32x4*)(buf + (128 + cl + 4 * n) * 4); }
#pragma unroll
        for (int ai = 0; ai < 2; ++ai)
#pragma unroll
            for (int m = 0; m < 4; ++m) { const size_t row = (size_t)u.pm * BM + ai * HALF + wr * 64 + m * 16 + fr; f32x4 o[2];
#pragma unroll
                for (int n = 0; n < 2; ++n)
#pragma unroll
                    for (int hh = 0; hh < 2; ++hh) {
                        const f32x2 ag = {acc[ai][0][m][n][2 * hh], acc[ai][0][m][n][2 * hh + 1]}, al = {acc[ai][1][m][n][2 * hh], acc[ai][1][m][n][2 * hh + 1]};
                        f32x2 g = ag * WINV + (f32x2){bg[n][2 * hh], bg[n][2 * hh + 1]}; g.x = fminf(g.x, 7.0f); g.y = fminf(g.y, 7.0f);
                        f32x2 l = al * WINV + (f32x2){bl[n][2 * hh], bl[n][2 * hh + 1]};
                        l.x = __builtin_amdgcn_fmed3f(l.x, -6.0f, 8.0f); l.y = __builtin_amdgcn_fmed3f(l.y, -6.0f, 8.0f);
                        const f32x2 t = g * (-1.702f * LOG2E); f32x2 e; e.x = __builtin_amdgcn_exp2f(t.x); e.y = __builtin_amdgcn_exp2f(t.y);
                        const f32x2 d = e + 1.0f; f32x2 sg; sg.x = __builtin_amdgcn_rcpf(d.x); sg.y = __builtin_amdgcn_rcpf(d.y);
                        const f32x2 r = (g * sg) * l; o[n][2 * hh] = r.x; o[n][2 * hh + 1] = r.y; }
                u32x2 w; w.x = pack4_fp8_nc(o[0]); w.y = pack4_fp8_nc(o[1]); *(u32x2*)((unsigned char*)act + row * DE + col) = w; }
    }
};

struct EpiDown {
    static constexpr bool HAS_MID = false, META = true;
    unsigned char* y; const float* b_out; const int* list; const LAS int* cnt;
    __device__ __forceinline__ void mid(f32x4 (&)[2][2][4][2], const Unit&, int, int, int, int) const {}
    __device__ __forceinline__ unsigned meta_issue(const Unit& u, int tid) const {
        if (tid < 256) return __builtin_bit_cast(unsigned, b_out[(size_t)u.e * D + u.pn * BM + tid]);
        const int nv = cnt[u.e] - u.mt * BM, r = tid - 256; return (unsigned)list[u.e * LISTCAP + u.mt * BM + (r < nv ? r : 0)];
    }
    __device__ __forceinline__ void meta_finish(unsigned bits, LAS unsigned char* buf, int tid) const { ((LAS unsigned*)buf)[tid] = bits; }
    __device__ __forceinline__ void run(const f32x4 (&acc)[2][2][4][2], const Unit& u, int wr, int wc, int fr, int fq, const LAS unsigned char* buf) const {
        const int cl = wc * 64 + 16 * fq, col = u.pn * BM + cl; const int nvalid = cnt[u.e] - u.mt * BM;
        f32x4 bv[2][2];
#pragma unroll
        for (int bj = 0; bj < 2; ++bj)
#pragma unroll
            for (int n = 0; n < 2; ++n) bv[bj][n] = *(const LAS f32x4*)(buf + (cl + 8 * bj + 4 * n) * 4);
#pragma unroll
        for (int ai = 0; ai < 2; ++ai)
#pragma unroll
            for (int m = 0; m < 4; ++m) { const int rl = ai * HALF + wr * 64 + m * 16 + fr; const int aid = ((const LAS int*)buf)[256 + rl]; u32x4 w;
#pragma unroll
                for (int bj = 0; bj < 2; ++bj)
#pragma unroll
                    for (int n = 0; n < 2; ++n) w[2 * bj + n] = pack4_fp8(acc[ai][bj][m][n] * WINV + bv[bj][n]);
                if (rl < nvalid) *(u32x4*)(y + (size_t)aid * D + col) = w; }
    }
};
}

struct XItem { const float* src; unsigned char* dst; };
__device__ __forceinline__ XItem xitem_decode(int r, const float* we1, unsigned char* W1, int lane) {
    const int kr = lane >> 3, n4 = lane & 7; const int e = r >> 9, q = r & 511, kb = q >> 6, nb = q & 63; const int n0 = 32 * nb, bj = n0 >> 10, j0 = n0 & 1023;
    const int drow = 256 * (j0 >> 7) + 64 * ((j0 >> 5) & 3) + 32 * bj; XItem d;
    d.src = we1 + (size_t)e * D * 2048 + (size_t)(128 * kb + 16 * kr) * 2048 + n0 + 4 * n4; d.dst = W1 + (size_t)e * 2048 * D + (size_t)(drow + 4 * n4) * D + 128 * kb + 16 * kr; return d;
}
__device__ __forceinline__ void xitem_load(const XItem& d, f32x4 (&v)[16]) {
#pragma unroll
    for (int i = 0; i < 16; ++i) v[i] = __builtin_nontemporal_load((const f32x4*)(d.src + (size_t)i * 2048));
}
__device__ __forceinline__ void xitem_store(const XItem& d, const f32x4 (&v)[16]) {
#pragma unroll
    for (int nn = 0; nn < 4; ++nn) { u32x4 o;
#pragma unroll
        for (int q = 0; q < 4; ++q) o[q] = pg8::pack4_fp8((f32x4){v[4 * q][nn], v[4 * q + 1][nn], v[4 * q + 2][nn], v[4 * q + 3][nn]} * pg8::WSCALE);
        __builtin_nontemporal_store(o, (u32x4*)(d.dst + (size_t)nn * D)); }
}

namespace att {
constexpr int NSLOT = 7, LEAD = NSLOT - 4, L_K = 0, L_V = NSLOT * 8192, L_TAB = 2 * NSLOT * 8192, L_WS = L_TAB + 2048, L_OST = L_WS + 2048, OST_STRIDE = 68, OST_BYTES = 16 * OST_STRIDE * 4;
__device__ __forceinline__ int crow(int r, int hi) { return (r & 3) + 8 * (r >> 2) + 4 * hi; }
__device__ __forceinline__ s16x4 vtr(const LAS char* p) { typedef short v4i16_t __attribute__((ext_vector_type(4))); return __builtin_bit_cast(s16x4, __builtin_amdgcn_ds_read_tr16_b64_v4i16((LAS v4i16_t*)p)); }

template <bool FULL>
__device__ __forceinline__ void attn_units(int b0, int bstep, int nunits, int h, int qb, const bf16_t* Q, const bf16_t* Kt, const bf16_t* Vt, bf16_t* MIX, float* ssq_att,
                                           const float* rel_bias, const float* MH, const float* g_att, LAS unsigned char* lds) {
    const int tid = opaque_tid(), lane = tid & 63, r32 = lane & 31, hi = lane >> 5; const int wid = __builtin_amdgcn_readfirstlane(tid >> 6);
    const int q0 = qb * 256;
    LAS float* dt = (LAS float*)(lds + L_TAB);
    const float mh = MH[h], bfar = rel_bias[h * 257 + 256];
    if (tid < 320) dt[319 - tid] = (rel_bias[h * 257 + (tid < 256 ? tid : 256)] - bfar) * LOG2E;
    const int base = 4 * qb - 8, o = wid >> 1, qo = 32 * (wid & 1);
    const int i0 = FULL ? 0 : (base + 3 < 0 ? -(base + 3) : 0);
    constexpr int NPK = FULL ? 4 + LEAD : 4, NPV = FULL ? 3 + LEAD : 4;
    const int ch = lane & 7;
    const f32x4 g0 = *(const f32x4*)(g_att + h * 64 + ch * 8), g1 = *(const f32x4*)(g_att + h * 64 + ch * 8 + 4);
    const bf16_t* Qw = Q + ((size_t)b0 * SEQ + q0 + wid * 32 + r32) * 512 + h * 64 + hi * 8;
    bf16x8 qr[4];
#pragma unroll
    for (int d0 = 0; d0 < 4; ++d0) qr[d0] = *(const bf16x8*)(Qw + d0 * 16);
    const bf16_t* ksrc = Kt + ((size_t)b0 * SEQ + lane) * 512 + h * 64 + wid * 8;
    const bf16_t* vsrc = Vt + ((size_t)b0 * SEQ + 16 * (wid & 3) + (lane >> 2)) * 512 + h * 64 + (wid >> 2) * 32 + (lane & 3) * 8;
    const size_t ustride = (size_t)bstep * SEQ * 512;
#define ATT_DMA_K(kp, t) do { const int sl_ = ((t) - base) % NSLOT; glds16((kp) + (size_t)(t) * 64 * 512, (unsigned)__builtin_amdgcn_readfirstlane(lds_addr(lds + L_K + sl_ * 8192 + wid * 1024))); } while (0)
#define ATT_DMA_V(vp_, t) do { const int sl_ = ((t) - base) % NSLOT; glds16((vp_) + (size_t)(t) * 64 * 512, (unsigned)__builtin_amdgcn_readfirstlane(lds_addr(lds + L_V + sl_ * 8192 + wid * 1024))); } while (0)
#define ATT_PROLOGUE(kp, vp_) do { _Pragma("unroll") for (int j = 0; j < NPK; ++j) { const int t = base + i0 + j; if (t >= 0 && t <= base + 11) ATT_DMA_K(kp, t); if (j < NPV && t >= 0) ATT_DMA_V(vp_, t); } } while (0)
    f32x16 cfv;
    { const float cfar = (bfar - mh) * LOG2E;
#pragma unroll
      for (int r = 0; r < 16; ++r) cfv[r] = cfar; }
#define ATT_QK(S0, S1, sl) do { const LAS char* kb = (const LAS char*)(lds + L_K + (sl) * 8192 + hi * 1024 + r32 * 16); \
        _Pragma("unroll") for (int d0 = 0; d0 < 4; ++d0) { \
            const bf16x8 k0 = *(const LAS bf16x8*)(kb + d0 * 2048), k1 = *(const LAS bf16x8*)(kb + d0 * 2048 + 512); \
            S0 = __builtin_amdgcn_mfma_f32_32x32x16_bf16(k0, qr[d0], d0 == 0 ? cfv : S0, 0, 0, 0); \
            S1 = __builtin_amdgcn_mfma_f32_32x32x16_bf16(k1, qr[d0], d0 == 0 ? cfv : S1, 0, 0, 0); } } while (0)
#define ATT_BIAS(S0, S1, delta) do { const int R0 = 319 - (64 * (delta) + qo + r32 + 128 - 4 * hi); \
        _Pragma("unroll") for (int r = 0; r < 16; ++r) { S0[r] += dt[R0 + (r & 3) + 8 * (r >> 2)]; S1[r] += dt[R0 + 32 + (r & 3) + 8 * (r >> 2)]; } } while (0)
#define ATT_SPV(S0, S1, sl) do { float sacc = 0.f; \
        _Pragma("unroll") for (int r = 0; r < 16; ++r) { S0[r] = __builtin_amdgcn_exp2f(S0[r]); S1[r] = __builtin_amdgcn_exp2f(S1[r]); sacc += S0[r] + S1[r]; } \
        l_reg += sacc; \
        u32x4 pw[4]; \
        _Pragma("unroll") for (int j = 0; j < 4; ++j) { pw[0][j] = cvt_pk_bf16(S0[2 * j], S0[2 * j + 1]); pw[1][j] = cvt_pk_bf16(S0[8 + 2 * j], S0[8 + 2 * j + 1]); \
                                                         pw[2][j] = cvt_pk_bf16(S1[2 * j], S1[2 * j + 1]); pw[3][j] = cvt_pk_bf16(S1[8 + 2 * j], S1[8 + 2 * j + 1]); } \
        const LAS char* vp = (const LAS char*)(lds + L_V + (sl) * 8192 + ((lane >> 4) & 1) * 32 + (lane & 3) * 8 + (4 * hi + ((lane & 15) >> 2)) * 64); \
        _Pragma("unroll") for (int ks = 0; ks < 4; ++ks) { \
            const s16x4 l0 = vtr(vp + ks * 1024), h0 = vtr(vp + ks * 1024 + 512), l1 = vtr(vp + 4096 + ks * 1024), h1 = vtr(vp + 4096 + ks * 1024 + 512); \
            const bf16x8 v0 = (bf16x8){l0[0], l0[1], l0[2], l0[3], h0[0], h0[1], h0[2], h0[3]}, v1 = (bf16x8){l1[0], l1[1], l1[2], l1[3], h1[0], h1[1], h1[2], h1[3]}; \
            const bf16x8 pa = __builtin_bit_cast(bf16x8, pw[ks]); \
            o0 = __builtin_amdgcn_mfma_f32_32x32x16_bf16(pa, v0, o0, 0, 0, 0); \
            o1 = __builtin_amdgcn_mfma_f32_32x32x16_bf16(pa, v1, o1, 0, 0, 0); } } while (0)
    ATT_PROLOGUE(ksrc, vsrc);
#pragma unroll 1
    for (int u = 0; u < nunits; ++u) {
    const bool has_next = u + 1 < nunits;
    const size_t rowbase = (size_t)(b0 + bstep * u) * SEQ;
    f32x16 o0 = {}, o1 = {}; float l_reg = 0.f;
    if constexpr (FULL) {
        static_assert(LEAD == 3, "the counted waits below are written for a lead of 3 steps");
#define ATT_TOP(i, W) do { asm volatile("s_waitcnt vmcnt(" #W ")" ::: "memory"); __syncthreads(); \
        if ((i) + 4 + LEAD <= 11) ATT_DMA_K(ksrc, base + (i) + 4 + LEAD); if ((i) + 3 + LEAD <= 11) ATT_DMA_V(vsrc, base + (i) + 3 + LEAD); } while (0)
#define ATT_BODY(i, C0, C1, N0, N1) do { \
        if ((i) >= 6) ATT_BIAS(C0, C1, 8 - (i)); \
        ATT_QK(N0, N1, ((i) + 1 + o) % NSLOT); ATT_SPV(C0, C1, ((i) + o) % NSLOT); } while (0)
        f32x16 sa0, sa1, sb0, sb1;
        asm volatile("s_waitcnt vmcnt(4)" ::: "memory");
        __syncthreads();
        ATT_QK(sa0, sa1, o);
#pragma unroll 1
        for (int i = 0; i < 8; i += 2) {
            if (i == 6) ATT_TOP(i, 3); else ATT_TOP(i, 4);
            ATT_BODY(i, sa0, sa1, sb0, sb1);
            if (i == 6) ATT_TOP(i + 1, 1); else ATT_TOP(i + 1, 4);
            ATT_BODY(i + 1, sb0, sb1, sa0, sa1);
        }
        ATT_TOP(8, 0);
        if (has_next) {
#pragma unroll
            for (int d0 = 0; d0 < 4; ++d0) qr[d0] = *(const bf16x8*)(Qw + ustride + d0 * 16); }
        ATT_BIAS(sa0, sa1, 0);
        ATT_SPV(sa0, sa1, (8 + o) % NSLOT);
#undef ATT_BODY
#undef ATT_TOP
    } else {
#pragma unroll 1
        for (int i = i0; i <= 8; ++i) {
            VM_WAIT();
            __syncthreads();
            if (i < 8) { ATT_DMA_K(ksrc, base + i + 4); ATT_DMA_V(vsrc, base + i + 4); }
            if (base + i + o >= 0) {
                const int slot = (i + o) % NSLOT;
                f32x16 p0, p1;
                ATT_QK(p0, p1, slot);
                if (i >= 6) ATT_BIAS(p0, p1, 8 - i);
                ATT_SPV(p0, p1, slot);
            }
        }
        if (has_next) {
#pragma unroll
            for (int d0 = 0; d0 < 4; ++d0) qr[d0] = *(const bf16x8*)(Qw + ustride + d0 * 16); }
    }
    __syncthreads();
    Qw += ustride; ksrc += ustride; vsrc += ustride;
    if (has_next) ATT_PROLOGUE(ksrc, vsrc);
#undef ATT_DMA_K
#undef ATT_DMA_V
#undef ATT_PROLOGUE
#undef ATT_QK
#undef ATT_BIAS
#undef ATT_SPV
    l_reg += __shfl_xor(l_reg, 32);
    LAS float* wsf = (LAS float*)(lds + L_WS) + wid * 32;
    if (hi == 0) wsf[r32] = l_reg;
    LDS_WAIT();
    LAS float* stg = (LAS float*)(lds + L_OST + wid * OST_BYTES);
#pragma unroll
    for (int p = 0; p < 2; ++p) {
#pragma unroll
        for (int r = 8 * p; r < 8 * p + 8; ++r) { const int orow = crow(r, hi); const float rl = __builtin_amdgcn_rcpf(wsf[orow]);
            stg[(orow - 16 * p) * OST_STRIDE + r32] = o0[r] * rl; stg[(orow - 16 * p) * OST_STRIDE + 32 + r32] = o1[r] * rl; }
        LDS_WAIT();
#pragma unroll
        for (int i = 0; i < 2; ++i) { const int row = i * 8 + (lane >> 3);
            const f32x4 a = *(const LAS f32x4*)(stg + row * OST_STRIDE + ch * 8), bq = *(const LAS f32x4*)(stg + row * OST_STRIDE + ch * 8 + 4);
            float ss = (a[0] * a[0] + a[1] * a[1]) + (a[2] * a[2] + a[3] * a[3]) + (bq[0] * bq[0] + bq[1] * bq[1]) + (bq[2] * bq[2] + bq[3] * bq[3]);
            ss += __shfl_xor(ss, 1); ss += __shfl_xor(ss, 2); ss += __shfl_xor(ss, 4);
            const size_t tok = rowbase + q0 + wid * 32 + 16 * p + row;
            if (ch == 0) ssq_att[tok * 8 + h] = ss;
            *(u32x4*)(MIX + tok * D + h * 64 + ch * 8) = pg8::pack8(a * g0, bq * g1); }
        LDS_WAIT();
    }
    }
    __syncthreads();
}
}

namespace gm {
constexpr int L_RS = 131072, L_BS = 131072 + 2048;
__device__ __forceinline__ void gmlp_unit(int b, int blk, const bf16_t* GU, const bf16_t* GV, const float* ssq_gv, const bf16_t* wsb, const float* b_s, const float* gvn, const float* g_out,
                                          bf16_t* MIX, LAS unsigned char* lds) {
    const int tid = opaque_tid(), lane = tid & 63, r32 = lane & 31, hi = lane >> 5; const int wid = __builtin_amdgcn_readfirstlane(tid >> 6);
    const size_t t0 = (size_t)b * SEQ + (size_t)blk * 128;
    LAS float* bsl = (LAS float*)(lds + L_BS);
    {
        const int js = 16 * wid + (lane >> 2);
        const bf16_t* src = GV + (t0 + js) * 512 + (lane & 3) * 8;
        u32x4 vt[16];
#pragma unroll
        for (int i = 0; i < 16; ++i) vt[i] = *(const u32x4*)(src + i * 32);
        const f32x4 qa = *(const f32x4*)(ssq_gv + (t0 + js) * 8), qb_ = *(const f32x4*)(ssq_gv + (t0 + js) * 8 + 4);
        float rsg[4];
        rsg[0] = __builtin_amdgcn_rsqf((qa[0] + qa[1]) * (1.0f / 128.0f) + EPS); rsg[1] = __builtin_amdgcn_rsqf((qa[2] + qa[3]) * (1.0f / 128.0f) + EPS);
        rsg[2] = __builtin_amdgcn_rsqf((qb_[0] + qb_[1]) * (1.0f / 128.0f) + EPS); rsg[3] = __builtin_amdgcn_rsqf((qb_[2] + qb_[3]) * (1.0f / 128.0f) + EPS);
        bsl[tid] = b_s[tid];
#pragma unroll
        for (int i = 0; i < 16; ++i) { const float r_ = rsg[i >> 2]; u32x4 w_;
#pragma unroll
            for (int k = 0; k < 4; ++k) w_[k] = cvt_pk_bf16(__builtin_bit_cast(float, vt[i][k] << 16) * r_, __builtin_bit_cast(float, vt[i][k] & 0xffff0000u) * r_);
            *(LAS u32x4*)(lds + i * 8192 + wid * 1024 + lane * 16) = w_; }
    }
    __syncthreads();
    const int g = wid >> 1, chh = wid & 1;
    f32x16 acc[4][2];
#pragma unroll
    for (int ib = 0; ib < 4; ++ib) { acc[ib][0] = (f32x16){}; acc[ib][1] = (f32x16){}; }
    const LAS char* vp = (const LAS char*)(lds + (g * 4 + 2 * chh) * 8192 + ((lane >> 4) & 1) * 32 + (lane & 3) * 8 + (4 * hi + ((lane & 15) >> 2)) * 64);
    const u32x4* wp = (const u32x4*)(wsb + ((size_t)(g * 128 + r32) * 128 + 8 * hi));
    u32x4 wf[8][4];
#define GM_WLOAD(s_) do { _Pragma("unroll") for (int ib = 0; ib < 4; ++ib) { if (ib < 2 && (s_) >= 4) continue; wf[s_][ib] = wp[(32 * ib * 128 + 16 * (s_)) / 8]; } } while (0)
    GM_WLOAD(0); GM_WLOAD(1);
#pragma unroll
    for (int s = 0; s < 8; ++s) {
        if (s + 2 < 8) GM_WLOAD(s + 2);
        const s16x4 l0 = att::vtr(vp + s * 1024), h0 = att::vtr(vp + s * 1024 + 512), l1 = att::vtr(vp + 8192 + s * 1024), h1 = att::vtr(vp + 8192 + s * 1024 + 512);
        const bf16x8 v0 = (bf16x8){l0[0], l0[1], l0[2], l0[3], h0[0], h0[1], h0[2], h0[3]}, v1 = (bf16x8){l1[0], l1[1], l1[2], l1[3], h1[0], h1[1], h1[2], h1[3]};
#pragma unroll
        for (int ib = 0; ib < 4; ++ib) {
            if (ib < 2 && s >= 4) continue;
            const bf16x8 af = __builtin_bit_cast(bf16x8, wf[s][ib]);
            acc[ib][0] = __builtin_amdgcn_mfma_f32_32x32x16_bf16(af, v0, acc[ib][0], 0, 0, 0);
            acc[ib][1] = __builtin_amdgcn_mfma_f32_32x32x16_bf16(af, v1, acc[ib][1], 0, 0, 0);
        }
        asm volatile("" ::: "memory");
    }
#undef GM_WLOAD
    u32x4 uu[16];
#pragma unroll
    for (int rr = 0; rr < 16; ++rr) uu[rr] = *(const u32x4*)(GU + (t0 + 16 * wid + rr) * 512 + 8 * lane);
    __syncthreads();
    {
        const float gn0 = gvn[g * 128 + 64 * chh + r32], gn1 = gvn[g * 128 + 64 * chh + 32 + r32];
        LAS bf16_t* stg = (LAS bf16_t*)lds;
#pragma unroll
        for (int ib = 0; ib < 4; ++ib)
#pragma unroll
            for (int r = 0; r < 16; ++r) { const int i = 32 * ib + att::crow(r, hi); const float bb = bsl[g * 128 + i];
                const unsigned pk = cvt_pk_bf16(acc[ib][0][r] * gn0 + bb, acc[ib][1][r] * gn1 + bb);
                stg[i * 512 + g * 128 + 64 * chh + r32] = (bf16_t)(pk & 0xffffu); stg[i * 512 + g * 128 + 64 * chh + 32 + r32] = (bf16_t)(pk >> 16); }
    }
    __syncthreads();
    {
        const f32x4 go0 = *(const f32x4*)(g_out + 8 * lane), go1 = *(const f32x4*)(g_out + 8 * lane + 4);
#pragma unroll
        for (int rr = 0; rr < 16; ++rr) { const int i = 16 * wid + rr;
            const u32x4 gt = *(const LAS u32x4*)(lds + (size_t)i * 1024 + lane * 16);
            float v[8];
#pragma unroll
            for (int k = 0; k < 4; ++k) { v[2 * k] = __builtin_bit_cast(float, gt[k] << 16) * __builtin_bit_cast(float, uu[rr][k] << 16);
                                           v[2 * k + 1] = __builtin_bit_cast(float, gt[k] & 0xffff0000u) * __builtin_bit_cast(float, uu[rr][k] & 0xffff0000u); }
            float ss = 0.f;
#pragma unroll
            for (int k = 0; k < 8; ++k) ss += v[k] * v[k];
            ss = wave_sum(ss);
            const float rs = __builtin_amdgcn_rsqf(ss * (1.0f / 512.0f) + EPS);
            const f32x4 a = (f32x4){v[0], v[1], v[2], v[3]} * rs * go0, c = (f32x4){v[4], v[5], v[6], v[7]} * rs * go1;
            *(u32x4*)(MIX + (t0 + i) * D + 512 + 8 * lane) = pg8::pack8(a, c); }
    }
    __syncthreads();
}
}

#define XB_TMO      128
#define XB_XCNT(j)  (256  + 64 * (j))
#define XB_XSUB(j)  (1280 + 64 * (j))
#define XB_XGEN(j)  (2304 + 64 * (j))
#define XB_TOP      3328
#define XB_TOPGEN   3392
#define XCD_BAR_WORDS 3456
#define XB_SPIN_CAP (1u << 18)
__device__ __forceinline__ unsigned xb_ld(unsigned* p)              { return __hip_atomic_load(p, __ATOMIC_RELAXED, __HIP_MEMORY_SCOPE_AGENT); }
__device__ __forceinline__ unsigned xb_add(unsigned* p, unsigned v) { return __hip_atomic_fetch_add(p, v, __ATOMIC_RELAXED, __HIP_MEMORY_SCOPE_AGENT); }
__device__ __forceinline__ unsigned xb_xcc_id() { return (unsigned)__builtin_amdgcn_s_getreg((3 << 11) | 20) & 0xFu; }
#define XB_SPIN(cond, bar) do { unsigned _sp = 0; while (cond) { __builtin_amdgcn_s_sleep(1); \
    if ((++_sp & 255u) == 0u) { if (xb_ld(&(bar)[XB_TMO])) break; if (_sp > XB_SPIN_CAP) { atomicAdd(&(bar)[XB_TMO], 1u); break; } } } } while (0)
struct XcdBarrier { unsigned* bar; unsigned x; volatile LAS unsigned* st; };
__device__ __forceinline__ XcdBarrier xcd_barrier_post(unsigned* bar, volatile LAS unsigned* st) {
    XcdBarrier b; b.bar = bar; b.x = xb_xcc_id(); b.st = st;
    if (threadIdx.x == 0) (void)xb_add(&bar[XB_XCNT(b.x)], 1u);
    return b;
}
__device__ __forceinline__ void xcd_barrier_complete(unsigned* bar, unsigned x, unsigned& nloc, unsigned& nx) {
    const unsigned G = gridDim.x * gridDim.y * gridDim.z;
    unsigned sum, cnt, mine, sp = 0u;
    for (;;) {
        sum = 0u; cnt = 0u; mine = 0u;
#pragma unroll
        for (unsigned j = 0; j < 16; ++j) { const unsigned c = xb_ld(&bar[XB_XCNT(j)]); sum += c; cnt += (c > 0u) ? 1u : 0u; mine = (j == x) ? c : mine; }
        if (sum == G) break;
        __builtin_amdgcn_s_sleep(1);
        if ((++sp & 255u) == 0u) { if (xb_ld(&bar[XB_TMO])) break; if (sp > XB_SPIN_CAP) { atomicAdd(&bar[XB_TMO], 1u); break; } }
    }
    nloc = mine > 0u ? mine : 1u; nx = cnt > 0u ? cnt : 1u;
}
__device__ __forceinline__ void xcd_barrier(const XcdBarrier& b) {
    asm volatile("s_waitcnt vmcnt(0)" ::: "memory");
    __syncthreads();
    if (threadIdx.x == 0) {
        unsigned* bar = b.bar;
        __builtin_amdgcn_s_waitcnt(0);
        unsigned nloc = b.st[0], nx = b.st[1];
        if (nloc == 0u) { xcd_barrier_complete(bar, b.x, nloc, nx); b.st[0] = nloc; b.st[1] = nx; }
        const unsigned old = xb_add(&bar[XB_XSUB(b.x)], 1u);
        const unsigned gen = old / nloc;
        if (old + 1u == (gen + 1u) * nloc) {
            __builtin_amdgcn_fence(__ATOMIC_RELEASE, "agent");
            asm volatile("s_waitcnt vmcnt(0)" ::: "memory");
            const unsigned og = xb_add(&bar[XB_TOP], 1u);
            const unsigned tg = og / nx;
            if (og + 1u == (tg + 1u) * nx) xb_add(&bar[XB_TOPGEN], 1u);
            else XB_SPIN(xb_ld(&bar[XB_TOPGEN]) == tg, bar);
            __builtin_amdgcn_fence(__ATOMIC_ACQUIRE, "agent");
            xb_add(&bar[XB_XGEN(b.x)], 1u);
            asm volatile("s_waitcnt vmcnt(0)" ::: "memory");
        } else {
            XB_SPIN(xb_ld(&bar[XB_XGEN(b.x)]) == gen, bar);
            __builtin_amdgcn_fence(__ATOMIC_ACQUIRE, "agent");
            asm volatile("s_waitcnt vmcnt(0)" ::: "memory");
        }
    }
    __syncthreads();
}

struct Args { const float* in[19]; float* out; unsigned char* ws; int ph_lo, ph_hi; };
enum { I_X = 0, I_GMIX, I_WIN, I_QG, I_KG, I_RELB, I_GVN, I_WS, I_BS, I_GATT, I_GGM, I_WOUT, I_GMOE, I_WR, I_BR, I_WE1, I_BE1, I_WE2, I_BE2 };

template <int KT, bool FP8OUT>
__device__ __forceinline__ void transpose_item(const float* W, int K, int N, void* WT, int dst_row0, int k0, int n0, float scale, int lane) {
    constexpr int KL = KT / 8;
    static_assert((FP8OUT && KL == 16) || (!FP8OUT && KL == 8), "16 bytes per lane and column");
    f32x4 v[KL];
    const int kr = lane >> 3, n4 = lane & 7;
    const float* src = W + (size_t)(k0 + KL * kr) * N + n0 + 4 * n4;
#pragma unroll
    for (int i = 0; i < KL; ++i) v[i] = __builtin_nontemporal_load((const f32x4*)(src + (size_t)i * N));
#pragma unroll
    for (int nn = 0; nn < 4; ++nn) {
        u32x4 o;
        if constexpr (FP8OUT) {
#pragma unroll
            for (int q = 0; q < 4; ++q) o[q] = pg8::pack4_fp8((f32x4){v[4 * q][nn], v[4 * q + 1][nn], v[4 * q + 2][nn], v[4 * q + 3][nn]} * scale);
            __builtin_nontemporal_store(o, (u32x4*)((unsigned char*)WT + (size_t)(dst_row0 + 4 * n4 + nn) * K + k0 + 16 * kr));
        } else {
#pragma unroll
            for (int q = 0; q < 4; ++q) o[q] = cvt_pk_bf16(v[2 * q][nn], v[2 * q + 1][nn]);
            *(u32x4*)((bf16_t*)WT + (size_t)(dst_row0 + 4 * n4 + nn) * K + k0 + 8 * kr) = o;
        }
    }
}

__device__ __forceinline__ void p4_router(LAS unsigned char* lds, const float* x, const bf16_t* MO, bf16_t* HB, float* GATES, int* LIST, unsigned* ECNT,
                                          const float* gmoe, const float* wr, const float* br, int G, int bx, const float* we1, unsigned char* W1c) {
    const int tid = opaque_tid(), lane = tid & 63; const int wid = __builtin_amdgcn_readfirstlane(tid >> 6);
    LAS unsigned short* whi = (LAS unsigned short*)lds; LAS unsigned short* wlo = (LAS unsigned short*)(lds + 32 * 2064);
    LAS float* part = (LAS float*)(lds + 132096);
    LAS int* lcnt = (LAS int*)(lds + LDS_LCNT);
    LAS float* ssqp = (LAS float*)(lds + LDS_LCNT + 256);
    LAS float* rsl = (LAS float*)(lds + LDS_LCNT + 768);
    LAS unsigned short* sel = (LAS unsigned short*)(lds + LDS_PT);
    {
        f32x4 wv[16]; float gk[16];
#pragma unroll
        for (int i = 0; i < 16; ++i) { const int idx4 = tid + 512 * i; wv[i] = *((const f32x4*)wr + idx4); gk[i] = gmoe[idx4 >> 3]; }
#pragma unroll
        for (int i = 0; i < 16; ++i) { const int idx4 = tid + 512 * i, k = idx4 >> 3, e0 = (idx4 & 7) * 4;
#pragma unroll
            for (int c = 0; c < 4; ++c) { const float v = wv[i][c] * gk[i];
                const unsigned hi = cvt_pk_bf16(v, 0.f) & 0xffffu; const float r = v - __builtin_bit_cast(float, hi << 16);
                whi[(e0 + c) * 1032 + k] = (unsigned short)hi; wlo[(e0 + c) * 1032 + k] = (unsigned short)(cvt_pk_bf16(r, 0.f) & 0xffffu); } }
    }
    if (tid < 32) lcnt[tid] = 0;
    __syncthreads();
    const int tt = lane & 15, q = lane >> 4, kb = 128 * wid + 8 * q;
    f32x4 gg[8];
#pragma unroll
    for (int s = 0; s < 4; ++s) { gg[2 * s] = *(const f32x4*)(gmoe + kb + 32 * s); gg[2 * s + 1] = *(const f32x4*)(gmoe + kb + 32 * s + 4); }
    const f32x4 b0 = *(const f32x4*)(br + 4 * q), b1 = *(const f32x4*)(br + 16 + 4 * q);
    const int nr = (T / 16 - bx + G - 1) / G;
    u32x4 ma[4], mb[4];
    XItem xd; f32x4 xw[16];
#define P4_LOAD(jr, MV) do { const size_t ro_ = (size_t)(16 * (bx + (jr) * G) + tt) * D + kb; \
        _Pragma("unroll") for (int s = 0; s < 4; ++s) { MV[s] = __builtin_nontemporal_load((const u32x4*)(MO + ro_ + 32 * s)); } } while (0)
    if (nr > 0) P4_LOAD(0, ma);
    if (nr > 1) P4_LOAD(1, mb);
    if (nr > 0) { xd = xitem_decode(8192 + bx * 8 + wid, we1, W1c, lane); xitem_load(xd, xw); }
#define P4_ROUND(j, MV, ITEM) do { \
        const int tb = 16 * (bx + j * G); \
        f32x4 hv[8]; float ssq = 0.f; \
_Pragma("unroll") \
        for (int s = 0; s < 4; ++s) { \
            hv[2 * s] = (f32x4){__builtin_bit_cast(float, MV[s][0] << 16), __builtin_bit_cast(float, MV[s][0] & 0xffff0000u), __builtin_bit_cast(float, MV[s][1] << 16), __builtin_bit_cast(float, MV[s][1] & 0xffff0000u)}; \
            hv[2 * s + 1] = (f32x4){__builtin_bit_cast(float, MV[s][2] << 16), __builtin_bit_cast(float, MV[s][2] & 0xffff0000u), __builtin_bit_cast(float, MV[s][3] << 16), __builtin_bit_cast(float, MV[s][3] & 0xffff0000u)}; } \
_Pragma("unroll") \
        for (int s = 0; s < 8; ++s) ssq += (hv[s][0] * hv[s][0] + hv[s][1] * hv[s][1]) + (hv[s][2] * hv[s][2] + hv[s][3] * hv[s][3]); \
        if (j + 2 < nr) { const size_t ro = (size_t)(16 * (bx + (j + 2) * G) + tt) * D + kb; \
_Pragma("unroll") \
            for (int s = 0; s < 4; ++s) { MV[s] = __builtin_nontemporal_load((const u32x4*)(MO + ro + 32 * s)); } } \
        f32x4 a0 = {0.f, 0.f, 0.f, 0.f}, a1 = {0.f, 0.f, 0.f, 0.f}; \
        const LAS unsigned char* w0p = (const LAS unsigned char*)whi + tt * 2064 + kb * 2; \
_Pragma("unroll") \
        for (int s = 0; s < 4; ++s) { \
            u32x4 hh, hl; \
_Pragma("unroll") \
            for (int c = 0; c < 2; ++c) \
_Pragma("unroll") \
                for (int d = 0; d < 2; ++d) { const float f0 = hv[2 * s + c][2 * d], f1 = hv[2 * s + c][2 * d + 1]; const unsigned ph = cvt_pk_bf16(f0, f1); \
                    hh[2 * c + d] = ph; hl[2 * c + d] = cvt_pk_bf16(f0 - __builtin_bit_cast(float, ph << 16), f1 - __builtin_bit_cast(float, ph & 0xffff0000u)); } \
            const bf16x8 bh = __builtin_bit_cast(bf16x8, hh), bl = __builtin_bit_cast(bf16x8, hl); \
            const bf16x8 w0h = *(const LAS bf16x8*)(w0p + 64 * s), w1h = *(const LAS bf16x8*)(w0p + 16 * 2064 + 64 * s); \
            const bf16x8 w0l = *(const LAS bf16x8*)(w0p + 32 * 2064 + 64 * s), w1l = *(const LAS bf16x8*)(w0p + 48 * 2064 + 64 * s); \
            a0 = __builtin_amdgcn_mfma_f32_16x16x32_bf16(w0h, bh, a0, 0, 0, 0); a1 = __builtin_amdgcn_mfma_f32_16x16x32_bf16(w1h, bh, a1, 0, 0, 0); \
            a0 = __builtin_amdgcn_mfma_f32_16x16x32_bf16(w0h, bl, a0, 0, 0, 0); a1 = __builtin_amdgcn_mfma_f32_16x16x32_bf16(w1h, bl, a1, 0, 0, 0); \
            a0 = __builtin_amdgcn_mfma_f32_16x16x32_bf16(w0l, bh, a0, 0, 0, 0); a1 = __builtin_amdgcn_mfma_f32_16x16x32_bf16(w1l, bh, a1, 0, 0, 0); \
        } \
        ssq += __shfl_xor(ssq, 16); ssq += __shfl_xor(ssq, 32); \
        if (q == 0) ssqp[wid * 16 + tt] = ssq; \
        if (wid >= 4) { *(LAS f32x4*)(part + (wid - 4) * 512 + lane * 8) = a0; *(LAS f32x4*)(part + (wid - 4) * 512 + lane * 8 + 4) = a1; } \
        __syncthreads(); \
        if (wid < 4) { \
            a0 += *(const LAS f32x4*)(part + wid * 512 + lane * 8); a1 += *(const LAS f32x4*)(part + wid * 512 + lane * 8 + 4); \
            if (wid > 0) { *(LAS f32x4*)(part + wid * 512 + lane * 8) = a0; *(LAS f32x4*)(part + wid * 512 + lane * 8 + 4) = a1; } \
        } \
        __syncthreads(); \
        if (wid == 0) { \
_Pragma("unroll") \
            for (int p = 1; p < 4; ++p) { a0 += *(const LAS f32x4*)(part + p * 512 + lane * 8); a1 += *(const LAS f32x4*)(part + p * 512 + lane * 8 + 4); } \
            float st = 0.f; \
_Pragma("unroll") \
            for (int w = 0; w < 8; ++w) st += ssqp[w * 16 + tt]; \
            const float rs = __builtin_amdgcn_rsqf(st * (1.0f / D) + EPS); \
            if (q == 0) rsl[tt] = rs; \
            LAS float* lg = part + 4 * 512; \
_Pragma("unroll") \
            for (int r = 0; r < 4; ++r) { lg[tt * 33 + 4 * q + r] = a0[r] * rs + b0[r]; lg[tt * 33 + 16 + 4 * q + r] = a1[r] * rs + b1[r]; } \
        } \
        __syncthreads(); \
        { \
            const LAS float* lg = part + 4 * 512; const int half = lane >> 5, tk = 2 * wid + half, ee = lane & 31; \
            float v = lg[tk * 33 + ee]; float tv[4]; int se[4]; \
_Pragma("unroll") \
            for (int p = 0; p < 4; ++p) { \
                float m = v; \
_Pragma("unroll") \
                for (int o = 1; o < 32; o <<= 1) m = fmaxf(m, __shfl_xor(m, o)); \
                const unsigned long long bal = __ballot(v == m); \
                const unsigned hb32 = half ? (unsigned)(bal >> 32) : (unsigned)bal; \
                const int bi = __builtin_ctz(hb32); \
                tv[p] = m; se[p] = bi; if (ee == bi) v = -3.0e38f; \
            } \
            if (ee == 0) { \
                float ex[4], sum = 0.f; \
_Pragma("unroll") \
                for (int p = 0; p < 4; ++p) { ex[p] = __builtin_amdgcn_exp2f((tv[p] - tv[0]) * LOG2E); sum += ex[p]; } \
                const float inv = 1.0f / sum; \
                *(f32x4*)(GATES + (size_t)(tb + tk) * 4) = (f32x4){ex[0] * inv, ex[1] * inv, ex[2] * inv, ex[3] * inv}; \
_Pragma("unroll") \
                for (int p = 0; p < 4; ++p) { const int pos = __hip_atomic_fetch_add(&lcnt[se[p]], 1, __ATOMIC_RELAXED, __HIP_MEMORY_SCOPE_WORKGROUP); sel[(j * 16 + tk) * 4 + p] = (unsigned short)((se[p] << 9) | pos); } \
            } \
        } \
        { \
            const float rr = rsl[tt]; unsigned char* hb = (unsigned char*)HB + (size_t)(tb + tt) * D + kb; \
_Pragma("unroll") \
            for (int s = 0; s < 4; ++s) { u32x2 w; w.x = pg8::pack4_fp8(hv[2 * s] * rr * gg[2 * s]); w.y = pg8::pack4_fp8(hv[2 * s + 1] * rr * gg[2 * s + 1]); *(u32x2*)(hb + 32 * s) = w; } \
        } \
        if (ITEM) { xitem_store(xd, xw); if (j + 2 < nr) { xd = xitem_decode(8192 + ((j >> 1) + 1) * 2048 + bx * 8 + wid, we1, W1c, lane); xitem_load(xd, xw); } } \
    } while (0)
    for (int j = 0; j < nr; j += 2) {
        P4_ROUND(j, ma, true);
        const int j1 = j + 1;
        if (j1 < nr) P4_ROUND(j1, mb, false);
    }
#undef P4_ROUND
#undef P4_LOAD
    __syncthreads();
    if (tid < 32) lcnt[32 + tid] = (int)__hip_atomic_fetch_add(ECNT + tid, (unsigned)lcnt[tid], __ATOMIC_RELAXED, __HIP_MEMORY_SCOPE_AGENT);
    __syncthreads();
    if (tid < nr * 64) { const unsigned sv = sel[tid]; const int e = sv >> 9, pos = sv & 511; const int jr = tid >> 6, tl = (tid >> 2) & 15, kk = tid & 3;
        LIST[e * LISTCAP + lcnt[32 + e] + pos] = (16 * (bx + jr * G) + tl) * 4 + kk; }
    __syncthreads();
}

__global__ void __launch_bounds__(512, 2) fwd_kernel(Args args) {
    extern __shared__ __attribute__((aligned(16))) unsigned char lds_raw[];
    LAS unsigned char* lds = (LAS unsigned char*)lds_raw;
    const int tid = threadIdx.x, lane = tid & 63; const int wid = __builtin_amdgcn_readfirstlane(tid >> 6);
    const int G = gridDim.x, bx = blockIdx.x;
    const int vcu = (G % 8 == 0) ? (bx % 8) * (G / 8) + bx / 8 : bx;
    unsigned char* ws = args.ws;
    unsigned* ctl = (unsigned*)(ws + WS_CTL);
    volatile LAS unsigned* MISC = (volatile LAS unsigned*)(lds + LDS_MISC);
    if (tid < 64) MISC[tid] = 0u;
    __syncthreads();
    XcdBarrier bar; bar.bar = ctl + CW_BAR; bar.x = 0; bar.st = nullptr;
#if !MK_SPLIT
    bar = xcd_barrier_post(ctl + CW_BAR, MISC + 8);
#define GRID_BAR() xcd_barrier(bar)
#else
#define GRID_BAR() do {} while (0)
#endif
    const int lo = args.ph_lo, hi_ph = args.ph_hi;
#define IN(k) (lo <= (k) && (k) < hi_ph)
#define BOTH(k) (IN(k) && IN((k) + 1))
    const float* x = args.in[I_X]; float* out = args.out;
    bf16_t* WIN = (bf16_t*)(ws + WS_WIN); bf16_t* WO = (bf16_t*)(ws + WS_WO); bf16_t* W1 = (bf16_t*)(ws + WS_W1); bf16_t* W2 = (bf16_t*)(ws + WS_W2);
    bf16_t* HB = (bf16_t*)(ws + WS_HB); bf16_t* XB = (bf16_t*)(ws + WS_XB); bf16_t* QB = (bf16_t*)(ws + WS_Q); bf16_t* MIX = (bf16_t*)(ws + WS_MIX);
    bf16_t* ACT = (bf16_t*)(ws + WS_ACT); unsigned char* Y = ws + WS_Y; bf16_t* MO = (bf16_t*)(ws + WS_MO);
    float* SSQGV = (float*)(ws + WS_SSQGV); float* SSQAT = (float*)(ws + WS_SSQAT); float* GATES = (float*)(ws + WS_GATES); float* MHp = (float*)(ws + WS_MH); bf16_t* WSB = (bf16_t*)(ws + WS_WSB);
    int* LIST = (int*)(ws + WS_LIST); unsigned* ECNT = ctl + CW_ECNT;
    const int gw = vcu * 8 + wid, NGW = G * 8;

    if (IN(0)) for (int rep = 0; rep < NREP(0); ++rep) {
        if (rep) GRID_BAR();
        constexpr int I_IN = 16 * 80, I_O = 16 * 32, I_1 = 8 * 64, I_2 = 8 * 32;
        constexpr int NITEMS = I_IN + I_O;
        for (int it = gw; it < NITEMS; it += NGW) {
            int r = it;
            if (r < I_IN) { const int kb = r / 80, nb = r % 80; transpose_item<64, false>(args.in[I_WIN], D, NPROJ, WIN, 32 * nb, 64 * kb, 32 * nb, 1.0f, lane); continue; } r -= I_IN;
            { const int kb = r / 32, nb = r % 32; transpose_item<64, false>(args.in[I_WOUT], D, D, WO, 32 * nb, 64 * kb, 32 * nb, 1.0f, lane); }
        }
        { const float* gmix = args.in[I_GMIX];
          f32x4 gg[4];
#pragma unroll
          for (int j = 0; j < 4; ++j) gg[j] = *(const f32x4*)(gmix + 4 * lane + 256 * j);
          f32x4 va[4][4], vb[4][4];
#define P0_LOAD(V, mm) do { _Pragma("unroll") for (int r = 0; r < 4; ++r) { const int m = (mm) + r * NGW < T ? (mm) + r * NGW : (mm); const f32x4* xr = (const f32x4*)(x + (size_t)m * D) + lane; \
              _Pragma("unroll") for (int j = 0; j < 4; ++j) V[r][j] = __builtin_nontemporal_load(xr + 64 * j); } } while (0)
#define P0_PROC(V, mm) do { float ss[4]; \
              _Pragma("unroll") for (int r = 0; r < 4; ++r) { float s = 0.f; \
                  _Pragma("unroll") for (int j = 0; j < 4; ++j) s += (V[r][j][0] * V[r][j][0] + V[r][j][1] * V[r][j][1]) + (V[r][j][2] * V[r][j][2] + V[r][j][3] * V[r][j][3]); \
                  ss[r] = s; } \
              _Pragma("unroll") for (int o = 1; o < 64; o <<= 1) { _Pragma("unroll") for (int r = 0; r < 4; ++r) ss[r] += __shfl_xor(ss[r], o); } \
              _Pragma("unroll") for (int r = 0; r < 4; ++r) { const int m = (mm) + r * NGW; if (m < T) { const float rs = __builtin_amdgcn_rsqf(ss[r] * (1.0f / D) + EPS); u32x2* o8 = (u32x2*)(XB + (size_t)m * D) + lane; \
                  _Pragma("unroll") for (int j = 0; j < 4; ++j) { const f32x4 z = V[r][j] * rs * gg[j]; u32x2 w; w.x = cvt_pk_bf16(z[0], z[1]); w.y = cvt_pk_bf16(z[2], z[3]); o8[64 * j] = w; } } } } while (0)
          if (gw < T) P0_LOAD(va, gw);
          for (int m0 = gw; m0 < T; m0 += 8 * NGW) {
              const int m1 = m0 + 4 * NGW, m2 = m0 + 8 * NGW;
              if (m1 < T) P0_LOAD(vb, m1);
              P0_PROC(va, m0);
              if (m2 < T) P0_LOAD(va, m2);
              if (m1 < T) P0_PROC(vb, m1);
          }
#undef P0_LOAD
#undef P0_PROC
          }
        if (bx < 8 && wid == 0) {
            const int h = bx; const float* rb = args.in[I_RELB] + h * 257;
            float bv[5];
#pragma unroll
            for (int i = 0; i < 5; ++i) { const int idx = lane + 64 * i; bv[i] = rb[idx < 257 ? idx : 256]; }
            const float qv = fabsf(args.in[I_QG][lane]), kv = fabsf(args.in[I_KG][lane]);
            float mb = fmaxf(fmaxf(fmaxf(bv[0], bv[1]), fmaxf(bv[2], bv[3])), bv[4]);
            mb = wave_max(mb); const float mq = wave_max(qv), mk = wave_max(kv);
            if (lane == 0) MHp[h] = 8.0f * mq * mk + mb;
        }
        if (bx >= 8 && bx < 136) {
            const int idx = (bx - 8) * 512 + tid, jj = idx & 127, s_ = jj >> 4, hi_ = (jj >> 3) & 1, e_ = jj & 7;
            const int j = 16 * s_ + (e_ < 4 ? 4 * hi_ + e_ : 8 + 4 * hi_ + (e_ - 4));
            WSB[idx] = (bf16_t)(cvt_pk_bf16(args.in[I_WS][(idx & ~127) + j], 0.f) & 0xffffu);
        }
        __syncthreads();
        if (BOTH(0)) GRID_BAR();
    }

#define P1_BODY() do { pg8::DenseSched S; S.o.init(T / 256, NPROJ / 256, G, bx); S.A = (const char*)XB; S.Bt = (const char*)WIN; \
        pg8::EpiInProj E{QB, args.in[I_QG], args.in[I_KG], SSQGV}; \
        pg8::gemm_phase<pg8::EpiInProj, pg8::DenseSched, true, true>(lds, S, E); } while (0)
    if (IN(1)) {
        P1_BODY();
#if PROBE_REP == 1
        GRID_BAR(); P1_BODY();
#endif
        if (BOTH(1)) GRID_BAR();
    }

#define P2A_BODY() do { const int qb = bx & 15, h = (bx >> 4) & 7, b0 = bx >> 7; \
        if (qb >= 2) att::attn_units<true>(b0, 2, 4, h, qb, QB, QB + QSTRIDE, QB + 2 * QSTRIDE, MIX, SSQAT, args.in[I_RELB], MHp, args.in[I_GATT], lds); \
        else att::attn_units<false>(b0, 2, 4, h, qb, QB, QB + QSTRIDE, QB + 2 * QSTRIDE, MIX, SSQAT, args.in[I_RELB], MHp, args.in[I_GATT], lds); } while (0)
#define P2G_BODY() do { for (int u = bx; u < 256; u += G) \
                gm::gmlp_unit(u >> 5, u & 31, QB + 3 * QSTRIDE, QB + 4 * QSTRIDE, SSQGV, WSB, args.in[I_BS], args.in[I_GVN], args.in[I_GGM], MIX, lds); } while (0)
    if (IN(2)) {
        P2A_BODY();
#if PROBE_REP == 2
        P2A_BODY();
#endif
        for (int rep = 0; rep < NREP(9); ++rep) P2G_BODY();
        if (BOTH(2)) GRID_BAR();
    }

#define P3_BODY() do { pg8::DenseSched S; S.o.init(T / 256, D / 256, G, bx); S.A = (const char*)MIX; S.Bt = (const char*)WO; \
        pg8::EpiOutProj E{MO, SSQAT, x}; \
        pg8::gemm_phase<pg8::EpiOutProj, pg8::DenseSched, true, true>(lds, S, E); } while (0)
#define P3X_BODY(first_) do { const int lane_ = opaque_tid() & 63; _Pragma("unroll 1") for (int s_ = 0; s_ < 4; ++s_) { \
        const XItem xd = xitem_decode((first_) + (bx >> 1) * 32 + wid * 4 + s_, args.in[I_WE1], (unsigned char*)W1, lane_); f32x4 xw[16]; xitem_load(xd, xw); xitem_store(xd, xw); } } while (0)
    if (IN(3)) {
        if (bx & 1) P3X_BODY(0);
        P3_BODY();
        if (!(bx & 1)) P3X_BODY(4096);
#if PROBE_REP == 3
        GRID_BAR(); P3_BODY();
#endif
        if (BOTH(3)) GRID_BAR();
    }

    if (IN(4)) {
#if PROBE_REP == 4
        p4_router(lds, x, MO, HB, GATES, (int*)ACT, ctl + CW_ECNT + 1024, args.in[I_GMOE], args.in[I_WR], args.in[I_BR], G, bx, args.in[I_WE1], (unsigned char*)W1);
        GRID_BAR();
#endif
        p4_router(lds, x, MO, HB, GATES, LIST, ECNT, args.in[I_GMOE], args.in[I_WR], args.in[I_BR], G, bx, args.in[I_WE1], (unsigned char*)W1);
        if (BOTH(4)) GRID_BAR();
    }

    LAS int* ptl = (LAS int*)(lds + LDS_PT); LAS int* cntl = (LAS int*)(lds + LDS_PT + 256);
    if (IN(5) || IN(6)) {
        if (tid < 64) { const int e = lane & 31; const int c = (int)__hip_atomic_load(ECNT + e, __ATOMIC_RELAXED, __HIP_MEMORY_SCOPE_AGENT); const int nt_e = (c + 255) >> 8;
            int incl = nt_e;
#pragma unroll
            for (int o = 1; o < 32; o <<= 1) { const int up = __shfl_up(incl, o, 32); if (e >= o) incl += up; }
            if (tid < 32) { cntl[e] = c; ptl[e + 1] = incl; if (e == 0) ptl[0] = 0; } }
        __syncthreads();
    }
    if (IN(5)) for (int rep = 0; rep < NREP(5); ++rep) {
        if (rep) GRID_BAR();
        pg8::GroupSched<true> S; S.o.init(ptl[32], 2048 / 256, G, bx); S.pt = ptl; S.cnt = cntl; S.A = (const char*)HB; S.Bt = (const char*)W1; S.nrows = 2048; S.list = LIST;
        pg8::EpiSwiglu E{ACT, args.in[I_BE1]};
        pg8::gemm_phase<pg8::EpiSwiglu, pg8::GroupSched<true>, true, true, true>(lds, S, E);
        {
            constexpr int I_2 = 8 * 32;
            for (;;) {
                __syncthreads();
                if (tid == 0) MISC[24] = __hip_atomic_fetch_add(ctl + CW_W2Q, 16u, __ATOMIC_RELAXED, __HIP_MEMORY_SCOPE_AGENT);
                __syncthreads();
                const int base = (int)MISC[24];
                if (base >= NE * I_2) break;
#pragma unroll 1
                for (int sub = 0; sub < 2; ++sub) { const int it = base + 2 * wid + sub;
                const int e = it / I_2, q = it % I_2, kb = q / 32, nb = q % 32;
                transpose_item<128, true>(args.in[I_WE2] + (size_t)e * DE * D, DE, D, (unsigned char*)W2 + (size_t)e * D * DE, 32 * nb, 128 * kb, 32 * nb, pg8::WSCALE, lane); }
            }
        }
        if (BOTH(5)) GRID_BAR();
    }
    if (IN(6)) for (int rep = 0; rep < NREP(6); ++rep) {
        if (rep) GRID_BAR();
        pg8::GroupSched<false> S; S.o.init(ptl[32], D / 256, G, bx); S.pt = ptl; S.cnt = cntl; S.A = (const char*)ACT; S.Bt = (const char*)W2; S.nrows = 1024; S.list = LIST;
        pg8::EpiDown E{Y, args.in[I_BE2], LIST, cntl};
        pg8::gemm_phase<pg8::EpiDown, pg8::GroupSched<false>, true, true, true, true>(lds, S, E);
        if (BOTH(6)) GRID_BAR();
    }
    if (IN(7)) for (int rep7 = 0; rep7 < NREP(7); ++rep7) {
        float* const dst7 = (NREP(7) == 2 && rep7 == 0) ? (float*)ACT : out;
        const int lane = opaque_tid() & 63;
#pragma unroll 2
        for (int m = gw; m < T; m += NGW) {
            const f32x4 gt = *(const f32x4*)(GATES + (size_t)m * 4);
            const u32x2* mr = (const u32x2*)(MO + (size_t)m * D) + lane; f32x4 v[4];
#pragma unroll
            for (int j = 0; j < 4; ++j) { const u32x2 mv = __builtin_nontemporal_load(mr + 64 * j);
                v[j] = (f32x4){__builtin_bit_cast(float, mv.x << 16), __builtin_bit_cast(float, mv.x & 0xffff0000u), __builtin_bit_cast(float, mv.y << 16), __builtin_bit_cast(float, mv.y & 0xffff0000u)}; }
#pragma unroll
            for (int k = 0; k < 4; ++k) { const unsigned* yr = (const unsigned*)(Y + ((size_t)m * 4 + k) * D) + lane; const float gk = gt[k];
#pragma unroll
                for (int j = 0; j < 4; ++j) { const unsigned w = __builtin_nontemporal_load(yr + 64 * j);
                    const f32x2 lo = __builtin_amdgcn_cvt_pk_f32_fp8((int)w, false), hi2 = __builtin_amdgcn_cvt_pk_f32_fp8((int)w, true);
                    v[j][0] += gk * lo[0]; v[j][1] += gk * lo[1]; v[j][2] += gk * hi2[0]; v[j][3] += gk * hi2[1]; } }
            f32x4* orow = (f32x4*)(dst7 + (size_t)m * D) + lane;
#pragma unroll
            for (int j = 0; j < 4; ++j) __builtin_nontemporal_store(v[j], orow + 64 * j);
        }
    }
#undef IN
#undef BOTH
}

extern "C" void kernel_launch(void* const* d_in, const int* in_sizes, int n_in, void* d_out, int out_size, void* d_ws, size_t ws_size, hipStream_t stream) {
    static int grid = 0;
    if (grid == 0) {
        if (n_in != 19 || in_sizes[0] != T * D || out_size != T * D || ws_size < WS_END) { fprintf(stderr, "kernel_launch: unexpected shapes (n_in %d, in0 %d, out %d, ws %zu)\n", n_in, n_in > 0 ? in_sizes[0] : -1, out_size, ws_size); grid = -1; return; }
        int dev = 0, cus = 0, per_cu = 0;
        if (hipGetDevice(&dev) != hipSuccess || hipDeviceGetAttribute(&cus, hipDeviceAttributeMultiprocessorCount, dev) != hipSuccess) { grid = -1; return; }
        if (hipFuncSetAttribute((const void*)fwd_kernel, hipFuncAttributeMaxDynamicSharedMemorySize, LDS_BYTES) != hipSuccess) { fprintf(stderr, "kernel_launch: hipFuncSetAttribute failed\n"); grid = -1; return; }
        if (hipOccupancyMaxActiveBlocksPerMultiprocessor(&per_cu, (const void*)fwd_kernel, 512, LDS_BYTES) != hipSuccess || per_cu < 1) fprintf(stderr, "kernel_launch: occupancy query reports %d\n", per_cu);
        (void)hipGetLastError();
        grid = cus;
        if (grid != 256) { fprintf(stderr, "kernel_launch: built for a 256-CU device (work maps assume 256 workgroups), found %d CUs; nothing launched\n", cus); grid = -1; return; }
    }
    if (grid < 0) return;
    (void)hipMemsetAsync((char*)d_ws + WS_CTL, 0, CTL_ZERO_BYTES, stream);
    Args a{};
    for (int i = 0; i < 19; ++i) a.in[i] = (const float*)d_in[i];
    a.out = (float*)d_out; a.ws = (unsigned char*)d_ws;
#if MK_SPLIT
    for (int p = 0; p < 8; ++p) { a.ph_lo = p; a.ph_hi = p + 1; hipLaunchKernelGGL(fwd_kernel, dim3(grid), dim3(512), LDS_BYTES, stream, a); }
#else
    a.ph_lo = 0; a.ph_hi = 8;
    hipLaunchKernelGGL(fwd_kernel, dim3(grid), dim3(512), LDS_BYTES, stream, a);
#endif
}
```
